# Optimizing an MI355X kernel written in HIP

```python
import jax, jax.numpy as jnp
from jax import lax
import numpy as np

D_MODEL = 1024
BATCH = 8
SEQ = 4096
DEPTH = 1

HEAD_DIM = 64
RET_HEADS = 8
DSA_HEADS = 8
RET_WIDTH = RET_HEADS * HEAD_DIM
DSA_WIDTH = DSA_HEADS * HEAD_DIM
MIX_WIDTH = RET_WIDTH + DSA_WIDTH
IDX_HEADS = 8
IDX_DIM = 64
TOPK_MAX = 256
RET_CHUNK = 128
Q_BLOCK = 128
D_FF = 2816
CONV_WIDTH = 3
ROPE_THETA = 10000.0
EPS = 1e-6
IN_SIZES = (RET_WIDTH, RET_WIDTH, RET_WIDTH, RET_WIDTH,
            DSA_WIDTH, HEAD_DIM, HEAD_DIM,
            IDX_HEADS * IDX_DIM, IDX_DIM, IDX_HEADS)
IN_WIDTH = 4 * RET_WIDTH + DSA_WIDTH + 2 * HEAD_DIM + IDX_HEADS * IDX_DIM + IDX_DIM + IDX_HEADS

kernel_name = "hymba_retention_dsa_convglu_sandwich"


def rms_norm(x, g):
    xf = x.astype(jnp.float32)
    y = xf * lax.rsqrt(jnp.mean(xf * xf, axis=-1, keepdims=True) + EPS)
    return (y * g.astype(jnp.float32)).astype(x.dtype)


def rope_tables(seq_len, dim):
    inv = ROPE_THETA ** (-jnp.arange(0, dim, 2, dtype=jnp.float32) / dim)
    ang = jnp.arange(seq_len, dtype=jnp.float32)[:, None] * inv[None, :]
    return jnp.cos(ang), jnp.sin(ang)


def apply_rope(x, cos, sin):
    shape = (cos.shape[0],) + (1,) * (x.ndim - 3) + (cos.shape[1],)
    c = cos.reshape(shape)
    s = sin.reshape(shape)
    xf = x.astype(jnp.float32)
    x1, x2 = jnp.split(xf, 2, axis=-1)
    return jnp.concatenate([x1 * c - x2 * s, x2 * c + x1 * s], axis=-1).astype(x.dtype)


def split_columns(p):
    pts, acc = [], 0
    for n in IN_SIZES[:-1]:
        acc += n
        pts.append(acc)
    return jnp.split(p, pts, axis=-1)


def retention(q, k, v, gate):
    B, S, H, d = q.shape
    C = RET_CHUNK
    N = S // C
    f32 = jnp.float32
    log_g = jnp.log(1.0 - 2.0 ** (-5.0 - jnp.arange(H, dtype=f32)))
    qf = q.astype(f32).reshape(B, N, C, H, d)
    kf = (k.astype(f32) * d ** -0.5).reshape(B, N, C, H, d)
    vf = v.astype(f32).reshape(B, N, C, H, d)
    pos = jnp.arange(C, dtype=f32)
    diff = pos[:, None] - pos[None, :]
    decay_in = jnp.where(diff >= 0, jnp.exp(log_g[:, None, None] * jnp.maximum(diff, 0.0)), 0.0)
    scores = jnp.einsum('bnchd,bnmhd->bnhcm', qf, kf) * decay_in[None, None]
    inner = jnp.einsum('bnhcm,bnmhd->bnchd', scores, vf)
    zeta = jnp.exp(log_g[:, None] * (C - 1.0 - pos)[None, :])
    chunk_state = jnp.einsum('bnmhk,hm,bnmhv->bnhkv', kf, zeta, vf)
    chunk_decay = jnp.exp(log_g * C)[None, :, None, None]

    def step(R, s):
        return chunk_decay * R + s, R

    _, prev = lax.scan(step, jnp.zeros((B, H, d, d), f32), jnp.moveaxis(chunk_state, 1, 0))
    prev = jnp.moveaxis(prev, 0, 1)
    xi = jnp.exp(log_g[:, None] * (pos + 1.0)[None, :])
    cross = jnp.einsum('bnchk,bnhkv,hc->bnchv', qf, prev, xi)
    o = (inner + cross).reshape(B, S, H, d)
    o = o * lax.rsqrt(jnp.mean(o * o, axis=-1, keepdims=True) + EPS)
    o = o * jax.nn.silu(gate.astype(f32).reshape(B, S, H, d))
    return o.reshape(B, S, H * d).astype(q.dtype)


def dsa_attention(q, k, v, qi, ki, wi):
    B, S, H, d = q.shape
    k_sel = min(TOPK_MAX, S // 4)
    NB = S // Q_BLOCK
    wi = wi * (IDX_HEADS ** -0.5 * IDX_DIM ** -0.5)

    def to_blocks(a):
        return jnp.moveaxis(a.reshape((B, NB, Q_BLOCK) + a.shape[2:]), 1, 0)

    key_pos = jnp.arange(S, dtype=jnp.int32)

    def block_fn(args):
        qb, qib, wib, blk = args
        t = blk * Q_BLOCK + jnp.arange(Q_BLOCK, dtype=jnp.int32)
        rel = jax.nn.relu(jnp.einsum('bthe,bse->bths', qib, ki))
        iscore = jnp.einsum('bths,bth->bts', rel, wib).astype(jnp.float32)
        causal = key_pos[None, :] <= t[:, None]
        iscore = jnp.where(causal[None], iscore, -jnp.inf)
        _, sel = lax.top_k(iscore, k_sel)
        valid = sel <= t[None, :, None]
        k_g = jax.vmap(lambda kb, ib: kb[ib])(k, sel)
        v_g = jax.vmap(lambda vb, ib: vb[ib])(v, sel)
        logits = jnp.einsum('bthd,btkd->bhtk', qb, k_g).astype(jnp.float32) * d ** -0.5
        logits = jnp.where(valid[:, None], logits, -1e30)
        p = jax.nn.softmax(logits, axis=-1).astype(v.dtype)
        return jnp.einsum('bhtk,btkd->bthd', p, v_g)

    out = lax.map(block_fn, (to_blocks(q), to_blocks(qi), to_blocks(wi),
                             jnp.arange(NB, dtype=jnp.int32)))
    return jnp.moveaxis(out, 0, 1).reshape(B, S, H * d)


def causal_dwconv(h, w, b):
    S = h.shape[1]
    hp = jnp.pad(h, ((0, 0), (CONV_WIDTH - 1, 0), (0, 0)))
    y = b
    for j in range(CONV_WIDTH):
        y = y + hp[:, j:j + S] * w[j]
    return y


def setup_inputs(seed: int = 0) -> dict:
    key = jax.random.key(seed)
    ks = jax.random.split(key, 11)
    f32 = jnp.float32
    nrm = lambda k, shape, scale: jax.random.normal(k, shape, f32) * scale
    gain = lambda k: 1.0 + 0.02 * jax.random.normal(k, (DEPTH, D_MODEL), f32)
    return {
        "x": jax.random.normal(ks[0], (BATCH, SEQ, D_MODEL), f32),
        "mix_norm_pre": gain(ks[1]),
        "mix_norm_post": gain(ks[2]),
        "w_in": nrm(ks[3], (DEPTH, D_MODEL, IN_WIDTH), D_MODEL ** -0.5),
        "w_out": nrm(ks[4], (DEPTH, MIX_WIDTH, D_MODEL), MIX_WIDTH ** -0.5),
        "ffn_norm_pre": gain(ks[5]),
        "ffn_norm_post": gain(ks[6]),
        "w_up": nrm(ks[7], (DEPTH, D_MODEL, 2 * D_FF), D_MODEL ** -0.5),
        "conv_w": nrm(ks[8], (DEPTH, CONV_WIDTH, 2 * D_FF), CONV_WIDTH ** -0.5),
        "conv_b": nrm(ks[9], (DEPTH, 2 * D_FF), 0.01),
        "w_down": nrm(ks[10], (DEPTH, D_FF, D_MODEL), D_FF ** -0.5),
    }


def reference(x, mix_norm_pre, mix_norm_post, w_in, w_out, ffn_norm_pre, ffn_norm_post,
              w_up, conv_w, conv_b, w_down):
    B, S, _ = x.shape
    cos_h, sin_h = rope_tables(S, HEAD_DIM)
    cos_i, sin_i = rope_tables(S, IDX_DIM)
    h = x
    for l in range(DEPTH):
        hn = rms_norm(h, mix_norm_pre[l])
        proj = hn @ w_in[l]
        rq, rk, rv, rg, aq, ak, av, iq, ik, iw = split_columns(proj)
        rq = apply_rope(rq.reshape(B, S, RET_HEADS, HEAD_DIM), cos_h, sin_h)
        rk = apply_rope(rk.reshape(B, S, RET_HEADS, HEAD_DIM), cos_h, sin_h)
        rv = rv.reshape(B, S, RET_HEADS, HEAD_DIM)
        ret_out = retention(rq, rk, rv, rg)
        aq = apply_rope(aq.reshape(B, S, DSA_HEADS, HEAD_DIM), cos_h, sin_h)
        ak = apply_rope(ak, cos_h, sin_h)
        iq = apply_rope(iq.reshape(B, S, IDX_HEADS, IDX_DIM), cos_i, sin_i)
        ik = apply_rope(ik, cos_i, sin_i)
        att_out = dsa_attention(aq, ak, av, iq, ik, iw)
        mixed = jnp.concatenate([ret_out, att_out], axis=-1) @ w_out[l]
        h = h + rms_norm(mixed, mix_norm_post[l])
        hn = rms_norm(h, ffn_norm_pre[l])
        up = causal_dwconv(hn @ w_up[l], conv_w[l], conv_b[l])
        g, u = jnp.split(up, 2, axis=-1)
        ffn = (jax.nn.silu(g) * u) @ w_down[l]
        h = h + rms_norm(ffn, ffn_norm_post[l])
    return h
```

```cpp
#include <hip/hip_runtime.h>
#include <hip/hip_cooperative_groups.h>
#include <cstdio>
#include <cstdint>
namespace cg = cooperative_groups;

#ifndef MK_MULTI
#define MK_MULTI 1
#endif

namespace pg8 {
#define PG8_LAS __attribute__((address_space(3)))
typedef unsigned short bf16_t;
typedef short bf16x8 __attribute__((ext_vector_type(8)));
typedef float f32x4 __attribute__((ext_vector_type(4)));
typedef unsigned u32x4 __attribute__((ext_vector_type(4)));
typedef unsigned u32x2 __attribute__((ext_vector_type(2)));
constexpr int BM = 256, BK = 64, HALF = 128, HTB = HALF * BK * 2, STAGE_BYTES = 8 * HTB, NXCD = 8, WGM = 8;

__host__ __device__ __forceinline__ int lds_byte(int r, int c) { const int st = (r >> 4) * 2 + (c >> 5), rr = r & 15, cc = c & 31, ob = rr * 64 + cc * 2; return st * 1024 + (ob ^ (((ob >> 9) & 1) << 5)); }
__host__ __device__ __forceinline__ void stage_rc(int b, int& R, int& C) { const int st = b / 1024, sb = b % 1024, swz = sb ^ (((sb >> 9) & 1) << 5); R = (st >> 1) * 16 + swz / 64; C = (st & 1) * 32 + (swz % 64) / 2; }
__host__ __device__ __forceinline__ int perm32(int rho) { const int n = rho >> 4, i = rho & 15; return 8 * (i >> 2) + 4 * n + (i & 3); }

struct Unit { int pm, pn; };
struct Gemm { const bf16_t* A; const bf16_t* Bt; int M, N, K; };

struct StaticOrder {
    int nM, nN, nwg, G, c;
    __host__ __device__ void init(int M, int N, int G_, int c_) { nM = M / BM; nN = N / BM; nwg = nM * nN; G = G_; c = c_; }
    __host__ __device__ bool next(int i, Unit& u) const {
        const long L = (long)i * G + c; if (L >= nwg) return false;
        int wgid = (int)L; { const int q = nwg / NXCD, r = nwg % NXCD, xcd = wgid % NXCD, off = wgid / NXCD; wgid = (xcd < r ? xcd * (q + 1) : r * (q + 1) + (xcd - r) * q) + off; }
        const int nig = WGM * nN, gid = wgid / nig, fm = gid * WGM, gsz = (nM - fm) < WGM ? (nM - fm) : WGM;
        u.pm = fm + ((wgid % nig) % gsz); u.pn = (wgid % nig) / gsz; return true;
    }
    __device__ __forceinline__ void a_ready(const Unit&) const {}
    __device__ __forceinline__ void done(const Unit&) const {}
};

__device__ __forceinline__ unsigned cvt_pk_bf16(float lo, float hi) { unsigned r; asm volatile("v_cvt_pk_bf16_f32 %0, %1, %2" : "=v"(r) : "v"(lo), "v"(hi)); return r; }

struct EpiStore {
    static constexpr bool PERM = true, AFTER_DRAIN = false, NEEDS_LDS = false;
    bf16_t* O; int ldc;
    __device__ __forceinline__ void operator()(const f32x4 (&acc)[2][2][4][2], const Unit& u, int wr, int wc, int fr, int fq, PG8_LAS unsigned char*) const {
        const int row0 = u.pm * BM + wr * 64 + fr; const int col0 = u.pn * BM + wc * 32 + 8 * fq;
#pragma unroll
        for (int ai = 0; ai < 2; ++ai)
#pragma unroll
            for (int m = 0; m < 4; ++m) { bf16_t* rowp = O + (size_t)(row0 + ai * HALF + m * 16) * ldc + col0;
#pragma unroll
                for (int bj = 0; bj < 2; ++bj) { const f32x4 v0 = acc[ai][bj][m][0], v1 = acc[ai][bj][m][1];
                    u32x4 w; w.x = cvt_pk_bf16(v0[0], v0[1]); w.y = cvt_pk_bf16(v0[2], v0[3]); w.z = cvt_pk_bf16(v1[0], v1[1]); w.w = cvt_pk_bf16(v1[2], v1[3]);
                    *(u32x4*)(rowp + bj * HALF) = w; } }
    }
};

template <class Epi, class Sched, bool ALIGN_EPI = false, bool SP2 = false>
__device__ __forceinline__ void gemm_phase(PG8_LAS unsigned char* lds, const Gemm g, const Sched& S, const Epi& E) {
    const int tid = threadIdx.x, wid = __builtin_amdgcn_readfirstlane(tid >> 6), lane = tid & 63, wr = wid >> 2, wc = wid & 3, fr = lane & 15, fq = lane >> 4;
    const int K = g.K, nt = K / BK;
    unsigned voffA[2], voffB[2];
#pragma unroll
    for (int i = 0; i < 2; ++i) { int R, C; stage_rc(tid * 16 + i * 8192, R, C); const int Rb = Epi::PERM ? ((R & ~31) + perm32(R & 31)) : R;
        voffA[i] = (unsigned)(R * K + C) * 2u; voffB[i] = (unsigned)(Rb * K + C) * 2u; }
    const size_t kstep = (size_t)(BK * 2);
    const size_t hstep = (size_t)HALF * K * 2;
    const size_t tstep = 2 * hstep;
    const unsigned ldsw = (unsigned)wid * 1024u;
    const int aoff = lds_byte(wr * 64 + fr, fq * 8), boff = lds_byte(wc * 32 + fr, fq * 8);
#define PG8_SA(b, h) (((b) * 2 + (h)) * HTB)
#define PG8_SB(b, h) ((4 + (b) * 2 + (h)) * HTB)
#define PG8_STAGE(bufoff, gbase, voff) do { _Pragma("unroll") for (int _i = 0; _i < 2; ++_i) \
        __builtin_amdgcn_global_load_lds((const unsigned*)((const char*)(gbase) + (voff)[_i]), (PG8_LAS unsigned*)(lds + (bufoff) + ldsw + _i * 8192), 16, 0, 0); } while (0)
#define PG8_LDA(dst, b, h) do { _Pragma("unroll") for (int m = 0; m < 4; ++m) _Pragma("unroll") for (int k = 0; k < 2; ++k) dst[m][k] = *(const PG8_LAS bf16x8*)(lds + PG8_SA(b, h) + aoff + m * 2048 + k * 1024); } while (0)
#define PG8_LDB(dst, b, h) do { _Pragma("unroll") for (int n = 0; n < 2; ++n) _Pragma("unroll") for (int k = 0; k < 2; ++k) dst[n][k] = *(const PG8_LAS bf16x8*)(lds + PG8_SB(b, h) + boff + n * 2048 + k * 1024); } while (0)
#define PG8_MMA(ai, bj, At, Bt) do { __builtin_amdgcn_s_setprio(1); _Pragma("unroll") for (int m = 0; m < 4; ++m) _Pragma("unroll") for (int n = 0; n < 2; ++n) _Pragma("unroll") for (int k = 0; k < 2; ++k) \
        acc[ai][bj][m][n] = __builtin_amdgcn_mfma_f32_16x16x32_bf16(Bt[n][k], At[m][k], acc[ai][bj][m][n], 0, 0, 0); __builtin_amdgcn_s_setprio(0); } while (0)
#define PG8_WAIT_V(n) asm volatile("s_waitcnt vmcnt(" #n ")" ::: "memory")
#define PG8_WAIT_L(n) asm volatile("s_waitcnt lgkmcnt(" #n ")" ::: "memory")
#define PG8_BAR __builtin_amdgcn_s_barrier()
#define PG8_SCHED __builtin_amdgcn_sched_barrier(0)
    Unit cur, nxt; int ui = 0;
    if (!S.next(0, cur)) return;
    f32x4 acc[2][2][4][2];
#pragma unroll
    for (int a = 0; a < 2; ++a)
#pragma unroll
        for (int b = 0; b < 2; ++b)
#pragma unroll
            for (int m = 0; m < 4; ++m)
#pragma unroll
                for (int n = 0; n < 2; ++n) acc[a][b][m][n] = (f32x4){0.f, 0.f, 0.f, 0.f};
    bf16x8 At[4][2], B0[2][2], B1[2][2];
    const char* cA = (const char*)g.A + (size_t)cur.pm * tstep; const char* cB = (const char*)g.Bt + (size_t)cur.pn * tstep;
    S.a_ready(cur);
    if constexpr (SP2) {
        PG8_STAGE(PG8_SB(0, 0), cB, voffB); PG8_STAGE(PG8_SB(0, 1), cB + hstep, voffB); PG8_STAGE(PG8_SA(0, 0), cA, voffA); PG8_STAGE(PG8_SA(0, 1), cA + hstep, voffA);
        if (wr == 1) PG8_BAR;
        PG8_WAIT_V(2); PG8_BAR;
        PG8_STAGE(PG8_SB(1, 0), cB + kstep, voffB); PG8_STAGE(PG8_SA(1, 0), cA + kstep, voffA); PG8_STAGE(PG8_SB(1, 1), cB + hstep + kstep, voffB);
        PG8_WAIT_V(6); PG8_BAR;
    } else {
        PG8_STAGE(PG8_SB(0, 0), cB, voffB); PG8_STAGE(PG8_SA(0, 0), cA, voffA); PG8_STAGE(PG8_SB(0, 1), cB + hstep, voffB); PG8_STAGE(PG8_SA(0, 1), cA + hstep, voffA);
        if (wr == 1) PG8_BAR;
        PG8_WAIT_V(4); PG8_BAR;
        PG8_STAGE(PG8_SB(1, 0), cB + kstep, voffB); PG8_STAGE(PG8_SA(1, 0), cA + kstep, voffA); PG8_STAGE(PG8_SB(1, 1), cB + hstep + kstep, voffB);
        PG8_WAIT_V(6); PG8_BAR;
    }
    for (;;) {
        const bool has_next = S.next(ui + 1, nxt);
        const char* nA = has_next ? (const char*)g.A + (size_t)nxt.pm * tstep : cA; const char* nB = has_next ? (const char*)g.Bt + (size_t)nxt.pn * tstep : cB;
        for (int t = 0; t < nt; t += 2) {
            const bool last = (t == nt - 2);
            const char* a1 = cA + (size_t)(t + 1) * kstep;
            const char* a2 = last ? nA : cA + (size_t)(t + 2) * kstep; const char* b2 = last ? nB : cB + (size_t)(t + 2) * kstep;
            const char* a3 = a2 + kstep; const char* b3 = b2 + kstep;
            if (last && has_next) S.a_ready(nxt);
            if constexpr (SP2) {
            PG8_LDB(B0, 0, 0); PG8_LDB(B1, 0, 1); PG8_SCHED; PG8_LDA(At, 0, 0); PG8_STAGE(PG8_SA(1, 1), a1 + hstep, voffA);
            PG8_WAIT_V(8); PG8_WAIT_L(0); PG8_BAR; PG8_MMA(0, 0, At, B0); PG8_MMA(0, 1, At, B1); PG8_BAR; PG8_SCHED;
            PG8_LDA(At, 0, 1); PG8_STAGE(PG8_SB(0, 0), b2, voffB); PG8_STAGE(PG8_SB(0, 1), b2 + hstep, voffB); PG8_STAGE(PG8_SA(0, 0), a2, voffA);
            PG8_WAIT_V(8); PG8_WAIT_L(0); PG8_BAR; PG8_MMA(1, 0, At, B0); PG8_MMA(1, 1, At, B1); PG8_BAR; PG8_SCHED;
            PG8_LDB(B0, 1, 0); PG8_LDB(B1, 1, 1); PG8_SCHED; PG8_LDA(At, 1, 0); PG8_STAGE(PG8_SA(0, 1), a2 + hstep, voffA);
            PG8_WAIT_V(8); PG8_WAIT_L(0); PG8_BAR; PG8_MMA(0, 0, At, B0); PG8_MMA(0, 1, At, B1); PG8_BAR; PG8_SCHED;
            PG8_LDA(At, 1, 1); PG8_STAGE(PG8_SB(1, 0), b3, voffB); PG8_STAGE(PG8_SB(1, 1), b3 + hstep, voffB); PG8_STAGE(PG8_SA(1, 0), a3, voffA);
            PG8_WAIT_V(8); PG8_WAIT_L(0); PG8_BAR; PG8_MMA(1, 0, At, B0); PG8_MMA(1, 1, At, B1); PG8_BAR; PG8_SCHED;
            } else {
            PG8_LDB(B0, 0, 0); PG8_SCHED; PG8_LDA(At, 0, 0); PG8_STAGE(PG8_SA(1, 1), a1 + hstep, voffA);
            PG8_WAIT_L(8); PG8_BAR; PG8_WAIT_L(0); PG8_MMA(0, 0, At, B0); PG8_BAR; PG8_SCHED;
            PG8_LDB(B1, 0, 1); PG8_STAGE(PG8_SB(0, 0), b2, voffB);
            PG8_BAR; PG8_WAIT_L(0); PG8_MMA(0, 1, At, B1); PG8_BAR;
            PG8_LDA(At, 0, 1); PG8_STAGE(PG8_SA(0, 0), a2, voffA);
            PG8_BAR; PG8_WAIT_L(0); PG8_MMA(1, 0, At, B0); PG8_BAR; PG8_SCHED;
            PG8_STAGE(PG8_SB(0, 1), b2 + hstep, voffB);
            PG8_WAIT_V(6); PG8_BAR; PG8_MMA(1, 1, At, B1); PG8_BAR;
            PG8_LDB(B0, 1, 0); PG8_SCHED; PG8_LDA(At, 1, 0); PG8_STAGE(PG8_SA(0, 1), a2 + hstep, voffA);
            PG8_WAIT_L(8); PG8_BAR; PG8_WAIT_L(0); PG8_MMA(0, 0, At, B0); PG8_BAR; PG8_SCHED;
            PG8_LDB(B1, 1, 1); PG8_STAGE(PG8_SB(1, 0), b3, voffB);
            PG8_BAR; PG8_WAIT_L(0); PG8_MMA(0, 1, At, B1); PG8_BAR;
            PG8_LDA(At, 1, 1); PG8_STAGE(PG8_SA(1, 0), a3, voffA);
            PG8_BAR; PG8_WAIT_L(0); PG8_MMA(1, 0, At, B0); PG8_BAR; PG8_SCHED;
            PG8_STAGE(PG8_SB(1, 1), b3 + hstep, voffB);
            PG8_WAIT_V(6); PG8_BAR; PG8_MMA(1, 1, At, B1); PG8_BAR;
            }
        }
        if constexpr (ALIGN_EPI) { if (wr == 0) PG8_BAR; }
        E(acc, cur, wr, wc, fr, fq, lds + STAGE_BYTES);
        if (!has_next) break;
#pragma unroll
        for (int a = 0; a < 2; ++a)
#pragma unroll
            for (int b = 0; b < 2; ++b)
#pragma unroll
                for (int m = 0; m < 4; ++m)
#pragma unroll
                    for (int n = 0; n < 2; ++n) acc[a][b][m][n] = (f32x4){0.f, 0.f, 0.f, 0.f};
        cur = nxt; cA = nA; cB = nB; ++ui;
        if constexpr (ALIGN_EPI) { if (wr == 1) PG8_BAR; }
    }
    PG8_WAIT_V(0);
    if constexpr (!ALIGN_EPI) { if (wr == 0) PG8_BAR; }
    PG8_BAR;
#undef PG8_SA
#undef PG8_SB
#undef PG8_STAGE
#undef PG8_LDA
#undef PG8_LDB
#undef PG8_MMA
#undef PG8_WAIT_V
#undef PG8_WAIT_L
#undef PG8_BAR
#undef PG8_SCHED
}
}

constexpr int BATCH = 8, SEQ = 4096, DM = 1024, M = BATCH * SEQ;
constexpr int NPROJ_LOG = 3272, NPROJ = 3328;
constexpr int DFF = 2816, NUP = 2 * DFF;
constexpr float EPS = 1e-6f;
constexpr int NWAVES = 8, NTHREADS = 512;
constexpr int NPHASE = 14;

typedef unsigned short bf16;
typedef float f32x4 __attribute__((ext_vector_type(4)));
typedef unsigned u32x4 __attribute__((ext_vector_type(4)));
typedef unsigned u32x2 __attribute__((ext_vector_type(2)));
#define LAS __attribute__((address_space(3)))

constexpr size_t MiB = 1u << 20;
constexpr size_t WS_CTL = 0;
constexpr size_t WS_COS = 1 * MiB, WS_SIN = WS_COS + 512 * 1024;
constexpr size_t WS_WIN = 2 * MiB;
constexpr size_t WS_WOUT = 9 * MiB;
constexpr size_t WS_WUP = 11 * MiB;
constexpr size_t WS_WDN = 22 * MiB;
constexpr size_t WS_HALO = 28 * MiB;
constexpr size_t WS_PART = 34 * MiB;
constexpr size_t WS_HN = 40 * MiB;
constexpr size_t WS_CAT = WS_HN;
constexpr size_t WS_BA = 104 * MiB;
constexpr size_t WS_BI = 144 * MiB;
constexpr size_t WS_IW = 180 * MiB;
constexpr size_t WS_ST = 181 * MiB;
constexpr size_t WS_PREV = 213 * MiB;
constexpr size_t WS_SEL = 229 * MiB;
constexpr size_t WS_KT = 245 * MiB;
constexpr size_t WS_VT = 277 * MiB;
constexpr size_t WS_HN2 = 309 * MiB;
constexpr size_t WS_BR = 373 * MiB;
constexpr size_t WS_SC = 245 * MiB;
constexpr size_t WS_MIX = 373 * MiB;
constexpr size_t WS_ACT = 104 * MiB;
constexpr size_t WS_FFN = 373 * MiB;
constexpr size_t WS_END = 512 * MiB;
constexpr size_t SC_BATCH = (size_t)128 * 128 * 528;

constexpr int LDS_BYTES = 147456;
constexpr int LDS_XCH = 131072;

__device__ __forceinline__ float bf2f(unsigned u) { return __uint_as_float(u << 16); }
__device__ __forceinline__ float bflo(unsigned w) { return __uint_as_float(w << 16); }
__device__ __forceinline__ float bfhi(unsigned w) { return __uint_as_float(w & 0xffff0000u); }
__device__ __forceinline__ unsigned f2bf(float f) { unsigned u = __float_as_uint(f); return (u + 0x7fffu + ((u >> 16) & 1u)) >> 16; }
__device__ __forceinline__ unsigned pk2(float lo, float hi) { return f2bf(lo) | (f2bf(hi) << 16); }
__device__ __forceinline__ float wave_sum(float v) {
#pragma unroll
    for (int o = 1; o < 64; o <<= 1) v += __shfl_xor(v, o);
    return v;
}
__device__ __forceinline__ float wave_max(float v) {
#pragma unroll
    for (int o = 1; o < 64; o <<= 1) v = fmaxf(v, __shfl_xor(v, o));
    return v;
}
__device__ __forceinline__ int wave_sum_i(int v) {
#pragma unroll
    for (int o = 1; o < 64; o <<= 1) v += __shfl_xor(v, o);
    return v;
}
__device__ __forceinline__ float silu_f(float x) { return x * __builtin_amdgcn_rcpf(1.0f + __builtin_amdgcn_exp2f(-1.4426950408889634f * x)); }
__device__ __forceinline__ float head_lg2(int h) { return log2f(1.0f - exp2f(-5.0f - (float)h)); }

struct Args { const float* in[11]; float* out; unsigned char* ws; int ph_lo, ph_hi, coop, pad; };

struct Frame {
    LAS unsigned char* lds;
    int tid, lane, wave, G, bid;
    const float *x, *g_mix_pre, *g_mix_post, *w_in, *w_out, *g_ffn_pre, *g_ffn_post, *w_up, *conv_w, *conv_b, *w_down;
    float* out; unsigned char* ws;
};

template <class CM>
__device__ __forceinline__ void p0_transpose_item(const float* W, int K, int ldw, int nlog, bf16* WT, LAS float* scr, int kb, int pb, int lane, CM cm) {
    const int k0 = 64 * kb, p0 = 32 * pb; const int q = lane & 31; const int c = cm(p0 + q);
#pragma unroll 8
    for (int i = 0; i < 32; ++i) { const int kk = 2 * i + (lane >> 5); scr[kk * 33 + q] = (c < nlog) ? W[(size_t)(k0 + kk) * ldw + c] : 0.f; }
    asm volatile("s_waitcnt lgkmcnt(0)" ::: "memory");
    const int c8 = lane & 7;
#pragma unroll
    for (int j = 0; j < 4; ++j) { const int n = (lane >> 3) + 8 * j; const LAS float* s = scr + (8 * c8) * 33 + n;
        u32x4 o; o.x = pk2(s[0 * 33], s[1 * 33]); o.y = pk2(s[2 * 33], s[3 * 33]); o.z = pk2(s[4 * 33], s[5 * 33]); o.w = pk2(s[6 * 33], s[7 * 33]);
        *(u32x4*)(WT + (size_t)(p0 + n) * K + k0 + 8 * c8) = o; }
    asm volatile("s_waitcnt lgkmcnt(0)" ::: "memory");
}
struct CmProj { __device__ __forceinline__ int operator()(int P) const { const int G = P >> 5, q = P & 31; return 64 * (G >> 1) + 16 * (G & 1) + (q & 15) + 32 * (q >> 4); } };
struct CmId   { __device__ __forceinline__ int operator()(int P) const { return P; } };
struct CmUp   { __device__ __forceinline__ int operator()(int P) const { return (P >> 8) * 128 + (P & 127) + ((P >> 7) & 1) * DFF; } };

__device__ __forceinline__ void sincos_d(float af, float& s, float& c) {
    const double a = (double)af; const double TWO_PI = 6.283185307179586476925286766559;
    const double n = rint(a * (1.0 / TWO_PI)); const double r = a - n * TWO_PI; const double r2 = r * r;
    double ps = 1.0 / 51090942171709440000.0 * -1.0;
    ps = ps * r2 + 1.0 / 121645100408832000.0;
    ps = ps * r2 - 1.0 / 355687428096000.0;
    ps = ps * r2 + 1.0 / 1307674368000.0;
    ps = ps * r2 - 1.0 / 6227020800.0;
    ps = ps * r2 + 1.0 / 39916800.0;
    ps = ps * r2 - 1.0 / 362880.0;
    ps = ps * r2 + 1.0 / 5040.0;
    ps = ps * r2 - 1.0 / 120.0;
    ps = ps * r2 + 1.0 / 6.0;
    ps = ps * r2 * -1.0 + 1.0;
    double pc = 1.0 / 1124000727777607680000.0;
    pc = pc * r2 - 1.0 / 2432902008176640000.0;
    pc = pc * r2 + 1.0 / 6402373705728000.0;
    pc = pc * r2 - 1.0 / 20922789888000.0;
    pc = pc * r2 + 1.0 / 87178291200.0;
    pc = pc * r2 - 1.0 / 479001600.0;
    pc = pc * r2 + 1.0 / 3628800.0;
    pc = pc * r2 - 1.0 / 40320.0;
    pc = pc * r2 + 1.0 / 720.0;
    pc = pc * r2 - 1.0 / 24.0;
    pc = pc * r2 + 0.5;
    pc = pc * r2 * -1.0 + 1.0;
    s = (float)(r * ps); c = (float)pc;
}

__device__ __forceinline__ void rms_row_to_bf16(const float* xrow, const float* g, bf16* orow, int lane) {
    const f32x4* xr = (const f32x4*)xrow + lane; const f32x4* gr = (const f32x4*)g + lane;
    f32x4 v[4]; float s = 0.f;
#pragma unroll
    for (int j = 0; j < 4; ++j) { v[j] = xr[64 * j]; s += (v[j].x * v[j].x + v[j].y * v[j].y) + (v[j].z * v[j].z + v[j].w * v[j].w); }
    const float rstd = 1.0f / sqrtf(wave_sum(s) * (1.f / DM) + EPS);
    unsigned long long* o8 = (unsigned long long*)orow + lane;
#pragma unroll
    for (int j = 0; j < 4; ++j) { const f32x4 gg = gr[64 * j];
        o8[64 * j] = (unsigned long long)pk2(v[j].x * rstd * gg.x, v[j].y * rstd * gg.y) | ((unsigned long long)pk2(v[j].z * rstd * gg.z, v[j].w * rstd * gg.w) << 32); }
}

__device__ __forceinline__ void phase_prologue(Frame& F) {
    LAS float* scr = (LAS float*)(F.lds + F.wave * 16384);
    const int gw = F.bid * NWAVES + F.wave, NGW = F.G * NWAVES;
    { float* COS = (float*)(F.ws + WS_COS); float* SIN = (float*)(F.ws + WS_SIN);
      for (int i = F.bid * NTHREADS + F.tid; i < SEQ * 32; i += F.G * NTHREADS) { const int pos = i >> 5, j = i & 31;
          const float inv = (float)exp2(-(double)j * (13.287712379549449 / 32.0));
          const float ang = (float)pos * inv; float s, c; sincos_d(ang, s, c); COS[i] = c; SIN[i] = s; } }
    constexpr int I_IN = (DM / 64) * (NPROJ / 32), I_OUT = (DM / 64) * (DM / 32), I_UP = (DM / 64) * (NUP / 32), I_DN = (DFF / 64) * (DM / 32);
    constexpr int NITEMS = I_IN + I_OUT + I_UP + I_DN;
    for (int it = gw; it < NITEMS; it += NGW) {
        int r = it;
        if (r < I_IN) { p0_transpose_item(F.w_in, DM, NPROJ_LOG, NPROJ_LOG, (bf16*)(F.ws + WS_WIN), scr, r / (NPROJ / 32), r % (NPROJ / 32), F.lane, CmProj()); continue; } r -= I_IN;
        if (r < I_OUT) { p0_transpose_item(F.w_out, DM, DM, DM, (bf16*)(F.ws + WS_WOUT), scr, r / (DM / 32), r % (DM / 32), F.lane, CmId()); continue; } r -= I_OUT;
        if (r < I_UP) { p0_transpose_item(F.w_up, DM, NUP, NUP, (bf16*)(F.ws + WS_WUP), scr, r / (NUP / 32), r % (NUP / 32), F.lane, CmUp()); continue; } r -= I_UP;
        p0_transpose_item(F.w_down, DFF, DM, DM, (bf16*)(F.ws + WS_WDN), scr, r / (DM / 32), r % (DM / 32), F.lane, CmId());
    }
    for (int m = gw; m < M; m += NGW) rms_row_to_bf16(F.x + (size_t)m * DM, F.g_mix_pre, (bf16*)(F.ws + WS_HN) + (size_t)m * DM, F.lane);
}

struct EpiProj {
    static constexpr bool PERM = false, AFTER_DRAIN = false;
    unsigned char* ws;
    __device__ __forceinline__ void operator()(const pg8::f32x4 (&acc)[2][2][4][2], const pg8::Unit& u, int wr, int wc, int fr, int fq, PG8_LAS unsigned char*) const {
        const float* COS = (const float*)(ws + WS_COS); const float* SIN = (const float*)(ws + WS_SIN);
        const int half = wc & 1, d0 = 16 * half + 4 * fq;
#pragma unroll
        for (int bj = 0; bj < 2; ++bj) {
            const int hb = 4 * u.pn + 2 * bj + (wc >> 1);
            if (hb >= 52) continue;
            const bool rope = (hb < 16) || (hb >= 32 && hb <= 40) || (hb >= 42 && hb <= 50);
            const float sc = ((hb >= 8 && hb < 16) || (hb >= 32 && hb < 40)) ? 0.125f : 1.0f;
            bf16* dst; int ld, col;
            if (hb < 32) { dst = (bf16*)(ws + WS_BR); ld = 2048; col = hb * 64; }
            else if (hb < 42) { dst = (bf16*)(ws + WS_BA); ld = 640; col = (hb - 32) * 64; }
            else { dst = (bf16*)(ws + WS_BI); ld = 576; col = (hb - 42) * 64; }
            bf16* tdst = nullptr;
            if (hb >= 8 && hb < 16) tdst = (bf16*)(ws + WS_KT) + (size_t)(hb - 8) * 64 * SEQ;
            if (hb >= 16 && hb < 24) tdst = (bf16*)(ws + WS_VT) + (size_t)(hb - 16) * 64 * SEQ;
#pragma unroll
            for (int ai = 0; ai < 2; ++ai)
#pragma unroll
                for (int m = 0; m < 4; ++m) {
                    const int row = u.pm * 256 + ai * 128 + wr * 64 + m * 16 + fr; const int pos = row & (SEQ - 1);
                    f32x4 v0 = acc[ai][bj][m][0], v1 = acc[ai][bj][m][1];
                    if (hb == 51) {
                        if (half == 0 && fq < 2) { float* iw = (float*)(ws + WS_IW) + (size_t)row * 8 + 4 * fq; *(f32x4*)iw = v0 * 0.044194173824159216f; }
                        continue;
                    }
                    if (rope) { const f32x4 cs = *(const f32x4*)(COS + pos * 32 + d0), sn = *(const f32x4*)(SIN + pos * 32 + d0);
                        const f32x4 o0 = v0 * cs - v1 * sn, o1 = v1 * cs + v0 * sn; v0 = o0 * sc; v1 = o1 * sc; }
                    u32x2 w0, w1; w0.x = pk2(v0[0], v0[1]); w0.y = pk2(v0[2], v0[3]); w1.x = pk2(v1[0], v1[1]); w1.y = pk2(v1[2], v1[3]);
                    bf16* p = dst + (size_t)row * ld + col + d0;
                    *(u32x2*)p = w0; *(u32x2*)(p + 32) = w1;
                    if (tdst) { bf16* tp = tdst + (size_t)(row >> 12) * (8 * 64 * SEQ) + (size_t)d0 * SEQ + pos;
                        tp[0 * SEQ] = (bf16)(w0.x & 0xffff); tp[1 * SEQ] = (bf16)(w0.x >> 16); tp[2 * SEQ] = (bf16)(w0.y & 0xffff); tp[3 * SEQ] = (bf16)(w0.y >> 16);
                        tp += 32 * SEQ;
                        tp[0 * SEQ] = (bf16)(w1.x & 0xffff); tp[1 * SEQ] = (bf16)(w1.x >> 16); tp[2 * SEQ] = (bf16)(w1.y & 0xffff); tp[3 * SEQ] = (bf16)(w1.y >> 16); }
                }
        }
    }
};

__device__ __forceinline__ void phase_ret_state(Frame& F) {
    const bf16* KT = (const bf16*)(F.ws + WS_KT); const bf16* VT = (const bf16*)(F.ws + WS_VT); float* ST = (float*)(F.ws + WS_ST);
    const int total = 2048 * 4096;
    for (int o = F.bid * NTHREADS + F.tid; o < total; o += F.G * NTHREADS) {
        const int unit = o >> 12, v = (o >> 6) & 63, k = o & 63, b = unit >> 8, n = (unit >> 3) & 31, h = unit & 7;
        const float lg = head_lg2(h);
        const u32x4* vp = (const u32x4*)(VT + ((size_t)((b * 8 + h) * 64 + v)) * SEQ + n * 128);
        const u32x4* kp = (const u32x4*)(KT + ((size_t)((b * 8 + h) * 64 + k)) * SEQ + n * 128);
        float acc = 0.f;
        for (int m8 = 0; m8 < 16; ++m8) { const u32x4 a = vp[m8], c = kp[m8];
#pragma unroll
            for (int j = 0; j < 4; ++j) { const int m = m8 * 8 + 2 * j;
                acc += bflo(a[j]) * bflo(c[j]) * exp2f(lg * (float)(127 - m)); acc += bfhi(a[j]) * bfhi(c[j]) * exp2f(lg * (float)(126 - m)); } }
        ST[o] = acc;
    }
}
__device__ __forceinline__ void phase_ret_scan(Frame& F) {
    const float* ST = (const float*)(F.ws + WS_ST); bf16* PV = (bf16*)(F.ws + WS_PREV);
    for (int e = F.bid * NTHREADS + F.tid; e < 8 * 8 * 4096; e += F.G * NTHREADS) {
        const int b = e >> 15, h = (e >> 12) & 7, vk = e & 4095; const float dec = exp2f(128.0f * head_lg2(h)); float R = 0.f;
        for (int n = 0; n < 32; ++n) { const size_t idx = ((size_t)((b * 32 + n) * 8 + h) << 12) + vk; PV[idx] = (bf16)f2bf(R); R = dec * R + ST[idx]; }
    }
}
__device__ __forceinline__ void phase_ret_out(Frame& F) {
    const bf16* BR = (const bf16*)(F.ws + WS_BR); const bf16* PV = (const bf16*)(F.ws + WS_PREV); bf16* CAT = (bf16*)(F.ws + WS_CAT);
    const int gw = F.bid * NWAVES + F.wave, NGW = F.G * NWAVES, lane = F.lane;
    for (int row = gw; row < M * 8; row += NGW) {
        const int tok = row >> 3, h = row & 7, t = tok & (SEQ - 1), n = t >> 7, c = t & 127, r0 = tok - c, b = tok >> 12;
        const float lg = head_lg2(h);
        float q[64];
        { const u32x4* qp = (const u32x4*)(BR + (size_t)tok * 2048 + h * 64);
#pragma unroll
          for (int i = 0; i < 8; ++i) { const u32x4 w = qp[i];
#pragma unroll
              for (int j = 0; j < 4; ++j) { q[i * 8 + 2 * j] = bflo(w[j]); q[i * 8 + 2 * j + 1] = bfhi(w[j]); } } }
        float s_lo = 0.f, s_hi = 0.f;
#pragma unroll
        for (int part = 0; part < 2; ++part) { const int m = lane + 64 * part;
            if (m <= c) { const u32x4* kp = (const u32x4*)(BR + (size_t)(r0 + m) * 2048 + 512 + h * 64); float d = 0.f;
#pragma unroll
                for (int i = 0; i < 8; ++i) { const u32x4 w = kp[i];
#pragma unroll
                    for (int j = 0; j < 4; ++j) { d += q[i * 8 + 2 * j] * bflo(w[j]); d += q[i * 8 + 2 * j + 1] * bfhi(w[j]); } }
                d *= exp2f(lg * (float)(c - m)); if (part == 0) s_lo = d; else s_hi = d; } }
        float o = 0.f;
        for (int m = 0; m <= c; ++m) { const float sm = __shfl(m < 64 ? s_lo : s_hi, m & 63); o += sm * bf2f(BR[(size_t)(r0 + m) * 2048 + 1024 + h * 64 + lane]); }
        { const int unit = (b * 32 + n) * 8 + h; const u32x4* pp = (const u32x4*)(PV + ((size_t)unit << 12) + lane * 64); float cr = 0.f;
#pragma unroll
          for (int i = 0; i < 8; ++i) { const u32x4 w = pp[i];
#pragma unroll
              for (int j = 0; j < 4; ++j) { cr += q[i * 8 + 2 * j] * bflo(w[j]); cr += q[i * 8 + 2 * j + 1] * bfhi(w[j]); } }
          o += cr * exp2f(lg * (float)(c + 1)); }
        const float ss = wave_sum(o * o); o *= 1.0f / sqrtf(ss * (1.f / 64.f) + EPS);
        const float g = bf2f(BR[(size_t)tok * 2048 + 1536 + h * 64 + lane]); o *= silu_f(g);
        CAT[(size_t)tok * 1024 + h * 64 + lane] = (bf16)f2bf(o);
    }
}
__device__ __forceinline__ size_t sc_off(int b, int qb) { return (size_t)b * SC_BATCH + (size_t)16384 * (size_t)(qb * (qb + 1) / 2); }
__device__ __forceinline__ void phase_idx_scores(Frame& F) {
    const bf16* BI = (const bf16*)(F.ws + WS_BI); const float* IW = (const float*)(F.ws + WS_IW); float* SC = (float*)(F.ws + WS_SC);
    const int gw = F.bid * NWAVES + F.wave, NGW = F.G * NWAVES, lane = F.lane;
    for (int task = gw; task < 8 * 1056; task += NGW) {
        const int b = task & 7; int r = task >> 3; int qb = 0; while (r >= 2 * (qb + 1)) { r -= 2 * (qb + 1); ++qb; } const int kc = r;
        const int s = kc * 64 + lane; const int pitch = (qb + 1) * 128;
        unsigned kr[32];
        { const u32x4* kp = (const u32x4*)(BI + (size_t)(b * SEQ + s) * 576 + 512);
#pragma unroll
          for (int i = 0; i < 8; ++i) { const u32x4 w = kp[i]; kr[4 * i] = w.x; kr[4 * i + 1] = w.y; kr[4 * i + 2] = w.z; kr[4 * i + 3] = w.w; } }
        float* scb = SC + sc_off(b, qb) + s;
        for (int tq = 0; tq < 128; ++tq) { const int tok = b * SEQ + qb * 128 + tq; float sc = 0.f;
            const f32x4 w0 = *(const f32x4*)(IW + (size_t)tok * 8), w1 = *(const f32x4*)(IW + (size_t)tok * 8 + 4);
#pragma unroll
            for (int h = 0; h < 8; ++h) { const u32x4* qp = (const u32x4*)(BI + (size_t)tok * 576 + h * 64); float d = 0.f;
#pragma unroll
                for (int i = 0; i < 8; ++i) { const u32x4 w = qp[i];
#pragma unroll
                    for (int j = 0; j < 4; ++j) { d += bflo(w[j]) * bflo(kr[4 * i + j]); d += bfhi(w[j]) * bfhi(kr[4 * i + j]); } }
                const float wh = h < 4 ? w0[h & 3] : w1[h & 3]; sc += wh * fmaxf(d, 0.f); }
            scb[(size_t)tq * pitch] = sc; }
    }
}
__device__ __forceinline__ void phase_select(Frame& F) {
    const float* SC = (const float*)(F.ws + WS_SC); bf16* SEL = (bf16*)(F.ws + WS_SEL);
    const int gw = F.bid * NWAVES + F.wave, NGW = F.G * NWAVES, lane = F.lane;
    const unsigned long long lt = (1ull << lane) - 1ull;
    for (int tok = gw; tok < M; tok += NGW) {
        const int t = tok & (SEQ - 1), b = tok >> 12; if (t < 256) continue;
        const int L = t + 1, qb = t >> 7, pitch = (qb + 1) * 128;
        const float* rowp = SC + sc_off(b, qb) + (size_t)(t & 127) * pitch;
        unsigned u[64];
#pragma unroll
        for (int j = 0; j < 64; ++j) { u[j] = 0u; if (64 * j < L) { const int s = 64 * j + lane; const float f = rowp[s]; unsigned bits = __float_as_uint(f); if (f == 0.f) bits = 0u;
            const unsigned key = (bits & 0x80000000u) ? ~bits : (bits | 0x80000000u); u[j] = (s < L) ? key : 0u; } }
        unsigned T = 0u;
        for (int bit = 31; bit >= 0; --bit) { const unsigned cand = T | (1u << bit); int cnt = 0;
#pragma unroll
            for (int j = 0; j < 64; ++j) cnt += (u[j] >= cand) ? 1 : 0;
            cnt = wave_sum_i(cnt); if (cnt >= 256) T = cand; }
        int ngt = 0;
#pragma unroll
        for (int j = 0; j < 64; ++j) ngt += (u[j] > T) ? 1 : 0;
        ngt = wave_sum_i(ngt); const int need_eq = 256 - ngt;
        int pos = 0, eqc = 0; bf16* out = SEL + (size_t)tok * 256;
#pragma unroll
        for (int j = 0; j < 64; ++j) { if (64 * j < L) {
            const bool gt = u[j] > T, eq = u[j] == T; const unsigned long long meq = __ballot(eq);
            const bool take = gt || (eq && (eqc + __popcll(meq & lt)) < need_eq); const unsigned long long mt = __ballot(take);
            if (take) out[pos + __popcll(mt & lt)] = (bf16)(64 * j + lane);
            pos += __popcll(mt); eqc += __popcll(meq); } }
    }
}
__device__ __forceinline__ void phase_attn(Frame& F) {
    const bf16* BA = (const bf16*)(F.ws + WS_BA); const bf16* SEL = (const bf16*)(F.ws + WS_SEL); bf16* CAT = (bf16*)(F.ws + WS_CAT);
    const int gw = F.bid * NWAVES + F.wave, NGW = F.G * NWAVES, lane = F.lane;
    LAS float* pl = (LAS float*)(F.lds + F.wave * 16384);
    LAS int* il = (LAS int*)(F.lds + F.wave * 16384 + 8192);
    for (int tok = gw; tok < M; tok += NGW) {
        const int t = tok & (SEQ - 1), b = tok >> 12; const int nk = t + 1 < 256 ? t + 1 : 256;
        float lg[8][4]; int idx[4];
#pragma unroll
        for (int i = 0; i < 4; ++i) { const int j = lane + 64 * i; idx[i] = (t < 256) ? (j < nk ? j : 0) : (int)SEL[(size_t)tok * 256 + j];
            unsigned kr[32]; { const u32x4* kp = (const u32x4*)(BA + (size_t)(b * SEQ + idx[i]) * 640 + 512);
#pragma unroll
                for (int c = 0; c < 8; ++c) { const u32x4 w = kp[c]; kr[4 * c] = w.x; kr[4 * c + 1] = w.y; kr[4 * c + 2] = w.z; kr[4 * c + 3] = w.w; } }
#pragma unroll
            for (int h = 0; h < 8; ++h) { const u32x4* qp = (const u32x4*)(BA + (size_t)tok * 640 + h * 64); float d = 0.f;
#pragma unroll
                for (int c = 0; c < 8; ++c) { const u32x4 w = qp[c];
#pragma unroll
                    for (int e = 0; e < 4; ++e) { d += bflo(w[e]) * bflo(kr[4 * c + e]); d += bfhi(w[e]) * bfhi(kr[4 * c + e]); } }
                lg[h][i] = (j < nk) ? d : -1e30f; } }
#pragma unroll
        for (int h = 0; h < 8; ++h) { float mx = fmaxf(fmaxf(lg[h][0], lg[h][1]), fmaxf(lg[h][2], lg[h][3])); mx = wave_max(mx); float e[4], sm = 0.f;
#pragma unroll
            for (int i = 0; i < 4; ++i) { e[i] = (lane + 64 * i < nk) ? __expf(lg[h][i] - mx) : 0.f; sm += e[i]; }
            sm = wave_sum(sm); const float inv = 1.0f / sm;
#pragma unroll
            for (int i = 0; i < 4; ++i) pl[(lane + 64 * i) * 8 + h] = e[i] * inv; }
#pragma unroll
        for (int i = 0; i < 4; ++i) il[lane + 64 * i] = idx[i];
        asm volatile("s_waitcnt lgkmcnt(0)" ::: "memory");
        float o[8];
#pragma unroll
        for (int h = 0; h < 8; ++h) o[h] = 0.f;
        for (int j = 0; j < nk; ++j) { const int kidx = il[j]; const float v = bf2f(BA[(size_t)(b * SEQ + kidx) * 640 + 576 + lane]);
            const f32x4 p0 = *(const LAS f32x4*)(pl + j * 8), p1 = *(const LAS f32x4*)(pl + j * 8 + 4);
            o[0] += p0.x * v; o[1] += p0.y * v; o[2] += p0.z * v; o[3] += p0.w * v; o[4] += p1.x * v; o[5] += p1.y * v; o[6] += p1.z * v; o[7] += p1.w * v; }
#pragma unroll
        for (int h = 0; h < 8; ++h) CAT[(size_t)tok * 1024 + 512 + h * 64 + lane] = (bf16)f2bf(o[h]);
        asm volatile("s_waitcnt lgkmcnt(0)" ::: "memory");
    }
}

__device__ __forceinline__ void phase_norm1(Frame& F) {
    const bf16* MIX = (const bf16*)(F.ws + WS_MIX); bf16* HN2 = (bf16*)(F.ws + WS_HN2);
    const int gw = F.bid * NWAVES + F.wave, NGW = F.G * NWAVES, lane = F.lane;
    for (int m = gw; m < M; m += NGW) {
        const u32x2* mr = (const u32x2*)(MIX + (size_t)m * DM) + lane; const f32x4* xr = (const f32x4*)(F.x + (size_t)m * DM) + lane;
        const f32x4* g1 = (const f32x4*)F.g_mix_post + lane; const f32x4* g2 = (const f32x4*)F.g_ffn_pre + lane;
        f32x4 v[4]; float s = 0.f;
#pragma unroll
        for (int j = 0; j < 4; ++j) { const u32x2 w = mr[64 * j]; v[j] = (f32x4){bflo(w.x), bfhi(w.x), bflo(w.y), bfhi(w.y)}; s += (v[j].x * v[j].x + v[j].y * v[j].y) + (v[j].z * v[j].z + v[j].w * v[j].w); }
        const float rstd = 1.0f / sqrtf(wave_sum(s) * (1.f / DM) + EPS); float s2 = 0.f;
        f32x4* orow = (f32x4*)(F.out + (size_t)m * DM) + lane;
#pragma unroll
        for (int j = 0; j < 4; ++j) { v[j] = xr[64 * j] + v[j] * rstd * g1[64 * j]; orow[64 * j] = v[j]; s2 += (v[j].x * v[j].x + v[j].y * v[j].y) + (v[j].z * v[j].z + v[j].w * v[j].w); }
        const float rstd2 = 1.0f / sqrtf(wave_sum(s2) * (1.f / DM) + EPS);
        unsigned long long* o8 = (unsigned long long*)(HN2 + (size_t)m * DM) + lane;
#pragma unroll
        for (int j = 0; j < 4; ++j) { const f32x4 gg = g2[64 * j];
            o8[64 * j] = (unsigned long long)pk2(v[j].x * rstd2 * gg.x, v[j].y * rstd2 * gg.y) | ((unsigned long long)pk2(v[j].z * rstd2 * gg.z, v[j].w * rstd2 * gg.w) << 32); }
    }
}
__device__ __forceinline__ void phase_norm2(Frame& F) {
    const bf16* FFN = (const bf16*)(F.ws + WS_FFN);
    const int gw = F.bid * NWAVES + F.wave, NGW = F.G * NWAVES, lane = F.lane;
    for (int m = gw; m < M; m += NGW) {
        const u32x2* mr = (const u32x2*)(FFN + (size_t)m * DM) + lane; const f32x4* g1 = (const f32x4*)F.g_ffn_post + lane;
        f32x4 v[4]; float s = 0.f;
#pragma unroll
        for (int j = 0; j < 4; ++j) { const u32x2 w = mr[64 * j]; v[j] = (f32x4){bflo(w.x), bfhi(w.x), bflo(w.y), bfhi(w.y)}; s += (v[j].x * v[j].x + v[j].y * v[j].y) + (v[j].z * v[j].z + v[j].w * v[j].w); }
        const float rstd = 1.0f / sqrtf(wave_sum(s) * (1.f / DM) + EPS);
        f32x4* orow = (f32x4*)(F.out + (size_t)m * DM) + lane;
#pragma unroll
        for (int j = 0; j < 4; ++j) orow[64 * j] = orow[64 * j] + v[j] * rstd * g1[64 * j];
    }
}

__device__ __forceinline__ float dpp_shr1(float old, float src) { return __int_as_float(__builtin_amdgcn_update_dpp(__float_as_int(old), __float_as_int(src), 0x111, 0xf, 0xf, false)); }
__device__ __forceinline__ float dpp_shr2(float old, float src) { return __int_as_float(__builtin_amdgcn_update_dpp(__float_as_int(old), __float_as_int(src), 0x112, 0xf, 0xf, false)); }
__device__ __forceinline__ float dpp_ror1(float src) { return __int_as_float(__builtin_amdgcn_update_dpp(0, __float_as_int(src), 0x121, 0xf, 0xf, false)); }
__device__ __forceinline__ float dpp_ror2(float src) { return __int_as_float(__builtin_amdgcn_update_dpp(0, __float_as_int(src), 0x122, 0xf, 0xf, false)); }
struct EpiUp {
    static constexpr bool PERM = true, AFTER_DRAIN = false;
    unsigned char* ws; const float* conv_w; const float* conv_b;
    __device__ __forceinline__ void operator()(const pg8::f32x4 (&acc)[2][2][4][2], const pg8::Unit& u, int wr, int wc, int fr, int fq, PG8_LAS unsigned char* xl) const {
        PG8_LAS float* X = (PG8_LAS float*)xl;
        const int cl = 32 * wc + 8 * fq;
        if (fr >= 14) {
#pragma unroll
            for (int ai = 0; ai < 2; ++ai)
#pragma unroll
                for (int bj = 0; bj < 2; ++bj)
#pragma unroll
                    for (int n = 0; n < 2; ++n) *(PG8_LAS f32x4*)(X + ((ai * 2 + wr) * 2 + (fr - 14)) * 256 + bj * 128 + cl + 4 * n) = acc[ai][bj][3][n];
            if (wr == 1) { float* H = (float*)(ws + WS_HALO) + ((size_t)(u.pm * 22 + u.pn) * 2 + (fr - 14)) * 256;
#pragma unroll
                for (int bj = 0; bj < 2; ++bj)
#pragma unroll
                    for (int n = 0; n < 2; ++n) *(f32x4*)(H + bj * 128 + cl + 4 * n) = acc[1][bj][3][n]; }
        }
        asm volatile("s_waitcnt lgkmcnt(0)" ::: "memory"); __builtin_amdgcn_s_barrier(); asm volatile("" ::: "memory");
        const bool seq_start = (u.pm & 15) == 0;
        bf16* ACT = (bf16*)(ws + WS_ACT);
#pragma unroll
        for (int n = 0; n < 2; ++n) {
            f32x4 w0[2], w1[2], w2[2], bb[2];
#pragma unroll
            for (int bj = 0; bj < 2; ++bj) { const int ch = bj * DFF + 128 * u.pn + cl + 4 * n;
                w0[bj] = *(const f32x4*)(conv_w + ch); w1[bj] = *(const f32x4*)(conv_w + NUP + ch); w2[bj] = *(const f32x4*)(conv_w + 2 * NUP + ch); bb[bj] = *(const f32x4*)(conv_b + ch); }
#pragma unroll
            for (int ai = 0; ai < 2; ++ai) {
                const bool has_pred = !(ai == 0 && wr == 0);
                const int pai = (wr == 1) ? ai : 0, pwr = (wr == 1) ? 0 : 1;
#pragma unroll
                for (int m = 0; m < 4; ++m) {
                    f32x4 y[2];
#pragma unroll
                    for (int bj = 0; bj < 2; ++bj) {
                        const f32x4 cur = acc[ai][bj][m][n]; f32x4 p1, p2;
                        if (m == 0) {
                            f32x4 x0 = (f32x4){0.f, 0.f, 0.f, 0.f}, x1 = x0;
                            if (has_pred) { const PG8_LAS float* xp = X + ((pai * 2 + pwr) * 2) * 256 + bj * 128 + cl + 4 * n; x0 = *(const PG8_LAS f32x4*)xp; x1 = *(const PG8_LAS f32x4*)(xp + 256); }
                            const f32x4 o2 = (fr == 0) ? x0 : x1;
#pragma unroll
                            for (int e = 0; e < 4; ++e) { p1[e] = dpp_shr1(x1[e], cur[e]); p2[e] = dpp_shr2(o2[e], cur[e]); }
                        } else {
                            const f32x4 prv = acc[ai][bj][m > 0 ? m - 1 : 0][n];
#pragma unroll
                            for (int e = 0; e < 4; ++e) { p1[e] = dpp_shr1(dpp_ror1(prv[e]), cur[e]); p2[e] = dpp_shr2(dpp_ror2(prv[e]), cur[e]); }
                        }
                        y[bj] = bb[bj] + w2[bj] * cur + w1[bj] * p1 + w0[bj] * p2;
                    }
                    const int row = u.pm * 256 + ai * 128 + wr * 64 + m * 16 + fr;
                    const bool partial = (ai == 0 && wr == 0 && m == 0 && fr < 2 && !seq_start);
                    if (partial) { float* P = (float*)(ws + WS_PART) + ((size_t)(u.pm * 22 + u.pn) * 2 + fr) * 256 + cl + 4 * n; *(f32x4*)P = y[0]; *(f32x4*)(P + 128) = y[1]; }
                    else { f32x4 a;
#pragma unroll
                        for (int e = 0; e < 4; ++e) a[e] = silu_f(y[0][e]) * y[1][e];
                        u32x2 pk; pk.x = pk2(a[0], a[1]); pk.y = pk2(a[2], a[3]);
                        *(u32x2*)(ACT + (size_t)row * DFF + 128 * u.pn + cl + 4 * n) = pk; }
                    asm volatile("" ::: "memory");
                }
            }
        }
    }
};
__device__ __forceinline__ void phase_fixup(Frame& F) {
    const float* H = (const float*)(F.ws + WS_HALO); const float* P = (const float*)(F.ws + WS_PART); bf16* ACT = (bf16*)(F.ws + WS_ACT);
    const int total = 128 * 22 * 2 * 128;
    for (int i = F.bid * NTHREADS + F.tid; i < total; i += F.G * NTHREADS) {
        const int c = i & 127, j = (i >> 7) & 1, pn = (i >> 8) % 22, pm = (i >> 8) / 22;
        if ((pm & 15) == 0) continue;
        const float* pp = P + ((size_t)(pm * 22 + pn) * 2 + j) * 256; const float* hp = H + ((size_t)((pm - 1) * 22 + pn) * 2) * 256;
        float y[2];
#pragma unroll
        for (int bj = 0; bj < 2; ++bj) { const int ch = bj * DFF + 128 * pn + c; const float w0 = F.conv_w[ch], w1 = F.conv_w[NUP + ch];
            const float h0 = hp[bj * 128 + c], h1 = hp[256 + bj * 128 + c];
            y[bj] = pp[bj * 128 + c] + (j == 0 ? (w1 * h1 + w0 * h0) : (w0 * h1)); }
        ACT[(size_t)(pm * 256 + j) * DFF + 128 * pn + c] = (bf16)f2bf(silu_f(y[0]) * y[1]);
    }
}

__global__ void __launch_bounds__(NTHREADS, 2) hymba_fwd(Args args) {
    extern __shared__ __attribute__((aligned(16))) unsigned char lds_raw[];
    Frame F;
    F.lds = (LAS unsigned char*)lds_raw;
    F.tid = threadIdx.x; F.lane = F.tid & 63; F.wave = __builtin_amdgcn_readfirstlane(F.tid >> 6); F.G = gridDim.x; F.bid = blockIdx.x;
    F.x = args.in[0]; F.g_mix_pre = args.in[1]; F.g_mix_post = args.in[2]; F.w_in = args.in[3]; F.w_out = args.in[4]; F.g_ffn_pre = args.in[5]; F.g_ffn_post = args.in[6];
    F.w_up = args.in[7]; F.conv_w = args.in[8]; F.conv_b = args.in[9]; F.w_down = args.in[10]; F.out = args.out; F.ws = args.ws;
    const int lo = args.ph_lo, hi = args.ph_hi;
    cg::grid_group grid = cg::this_grid();
#define IN(k) (lo <= (k) && (k) < hi)
#define SEAM(k) do { if (IN(k) && IN((k) + 1)) { if (args.coop) grid.sync(); } } while (0)
    if (IN(0)) { phase_prologue(F); } SEAM(0);
    if (IN(1)) { pg8::Gemm g{(const bf16*)(F.ws + WS_HN), (const bf16*)(F.ws + WS_WIN), M, NPROJ, DM}; pg8::StaticOrder S; S.init(M, NPROJ, F.G, F.bid);
        EpiProj E{F.ws}; pg8::gemm_phase<EpiProj, pg8::StaticOrder, true, true>(F.lds, g, S, E); } SEAM(1);
    if (IN(2)) { phase_ret_state(F); } SEAM(2);
    if (IN(3)) { phase_ret_scan(F); } SEAM(3);
    if (IN(4)) { phase_ret_out(F); } SEAM(4);
    if (IN(5)) { phase_idx_scores(F); } SEAM(5);
    if (IN(6)) { phase_select(F); } SEAM(6);
    if (IN(7)) { phase_attn(F); } SEAM(7);
    if (IN(8)) { pg8::Gemm g{(const bf16*)(F.ws + WS_CAT), (const bf16*)(F.ws + WS_WOUT), M, DM, DM}; pg8::StaticOrder S; S.init(M, DM, F.G, F.bid);
        pg8::EpiStore E{(bf16*)(F.ws + WS_MIX), DM}; pg8::gemm_phase<pg8::EpiStore, pg8::StaticOrder, true, true>(F.lds, g, S, E); } SEAM(8);
    if (IN(9)) { phase_norm1(F); } SEAM(9);
    if (IN(10)) { pg8::Gemm g{(const bf16*)(F.ws + WS_HN2), (const bf16*)(F.ws + WS_WUP), M, NUP, DM}; pg8::StaticOrder S; S.init(M, NUP, F.G, F.bid);
        EpiUp E{F.ws, F.conv_w, F.conv_b}; pg8::gemm_phase<EpiUp, pg8::StaticOrder, true, true>(F.lds, g, S, E); } SEAM(10);
    if (IN(11)) { phase_fixup(F); } SEAM(11);
    if (IN(12)) { pg8::Gemm g{(const bf16*)(F.ws + WS_ACT), (const bf16*)(F.ws + WS_WDN), M, DM, DFF}; pg8::StaticOrder S; S.init(M, DM, F.G, F.bid);
        pg8::EpiStore E{(bf16*)(F.ws + WS_FFN), DM}; pg8::gemm_phase<pg8::EpiStore, pg8::StaticOrder, true, true>(F.lds, g, S, E); } SEAM(12);
    if (IN(13)) { phase_norm2(F); }
#undef IN
#undef SEAM
}

extern "C" void kernel_launch(void* const* d_in, const int* in_sizes, int n_in, void* d_out, int out_size, void* d_ws, size_t ws_size, hipStream_t stream) {
    static int grid = 0;
    if (grid == 0) {
        if (n_in != 11 || in_sizes[0] != M * DM || out_size != M * DM || ws_size < WS_END) { fprintf(stderr, "kernel_launch: unexpected shapes (n_in %d, in0 %d, out %d, ws %zu)\n", n_in, n_in > 0 ? in_sizes[0] : -1, out_size, ws_size); grid = -1; return; }
        int dev = 0, cus = 0, per_cu = 0;
        hipGetDevice(&dev); hipDeviceGetAttribute(&cus, hipDeviceAttributeMultiprocessorCount, dev);
        hipFuncSetAttribute((const void*)hymba_fwd, hipFuncAttributeMaxDynamicSharedMemorySize, LDS_BYTES);
        hipOccupancyMaxActiveBlocksPerMultiprocessor(&per_cu, (const void*)hymba_fwd, NTHREADS, LDS_BYTES);
        if (per_cu < 1) { fprintf(stderr, "kernel_launch: occupancy query says %d blocks per CU\n", per_cu); per_cu = 1; }
        (void)hipGetLastError();
        grid = cus * 1;
    }
    if (grid < 0) return;
    Args a{};
    for (int i = 0; i < 11; ++i) a.in[i] = (const float*)d_in[i];
    a.out = (float*)d_out; a.ws = (unsigned char*)d_ws;
#if MK_MULTI
    for (int p = 0; p < NPHASE; ++p) { a.ph_lo = p; a.ph_hi = p + 1; a.coop = 0; hipLaunchKernelGGL(hymba_fwd, dim3(grid), dim3(NTHREADS), LDS_BYTES, stream, a); }
#else
    a.ph_lo = 0; a.ph_hi = NPHASE; a.coop = 1;
    void* kargs[] = {&a};
    hipError_t e = hipLaunchCooperativeKernel((const void*)hymba_fwd, dim3(grid), dim3(NTHREADS), kargs, LDS_BYTES, stream);
    if (e != hipSuccess) fprintf(stderr, "cooperative launch failed: %s (grid %d)\n", hipGetErrorString(e), grid);
#endif
}
```

```cpp
#include <hip/hip_runtime.h>
#include <hip/hip_cooperative_groups.h>
#include <cstdio>
#include <cstdint>
namespace cg = cooperative_groups;

#ifndef MK_MULTI
#define MK_MULTI 0
#endif

namespace pg8 {
#define PG8_LAS __attribute__((address_space(3)))
typedef unsigned short bf16_t;
typedef short bf16x8 __attribute__((ext_vector_type(8)));
typedef float f32x4 __attribute__((ext_vector_type(4)));
typedef unsigned u32x4 __attribute__((ext_vector_type(4)));
typedef unsigned u32x2 __attribute__((ext_vector_type(2)));
constexpr int BM = 256, BK = 64, HALF = 128, HTB = HALF * BK * 2, STAGE_BYTES = 8 * HTB, NXCD = 8, WGM = 8;

__host__ __device__ __forceinline__ int lds_byte(int r, int c) { const int st = (r >> 4) * 2 + (c >> 5), rr = r & 15, cc = c & 31, ob = rr * 64 + cc * 2; return st * 1024 + (ob ^ (((ob >> 9) & 1) << 5)); }
__host__ __device__ __forceinline__ void stage_rc(int b, int& R, int& C) { const int st = b / 1024, sb = b % 1024, swz = sb ^ (((sb >> 9) & 1) << 5); R = (st >> 1) * 16 + swz / 64; C = (st & 1) * 32 + (swz % 64) / 2; }
__host__ __device__ __forceinline__ int perm32(int rho) { const int n = rho >> 4, i = rho & 15; return 8 * (i >> 2) + 4 * n + (i & 3); }

struct Unit { int pm, pn; };
struct Gemm { const bf16_t* A; const bf16_t* Bt; int M, N, K; };

struct StaticOrder {
    int nM, nN, nwg, G, c;
    __host__ __device__ void init(int M, int N, int G_, int c_) { nM = M / BM; nN = N / BM; nwg = nM * nN; G = G_; c = c_; }
    __host__ __device__ bool next(int i, Unit& u) const {
        const long L = (long)i * G + c; if (L >= nwg) return false;
        int wgid = (int)L; { const int q = nwg / NXCD, r = nwg % NXCD, xcd = wgid % NXCD, off = wgid / NXCD; wgid = (xcd < r ? xcd * (q + 1) : r * (q + 1) + (xcd - r) * q) + off; }
        const int nig = WGM * nN, gid = wgid / nig, fm = gid * WGM, gsz = (nM - fm) < WGM ? (nM - fm) : WGM;
        u.pm = fm + ((wgid % nig) % gsz); u.pn = (wgid % nig) / gsz; return true;
    }
    __device__ __forceinline__ void a_ready(const Unit&) const {}
    __device__ __forceinline__ void done(const Unit&) const {}
};

__device__ __forceinline__ unsigned cvt_pk_bf16(float lo, float hi) { unsigned r; asm volatile("v_cvt_pk_bf16_f32 %0, %1, %2" : "=v"(r) : "v"(lo), "v"(hi)); return r; }

struct EpiStore {
    static constexpr bool PERM = true, AFTER_DRAIN = false, NEEDS_LDS = false;
    bf16_t* O; int ldc;
    __device__ __forceinline__ void operator()(const f32x4 (&acc)[2][2][4][2], const Unit& u, int wr, int wc, int fr, int fq, PG8_LAS unsigned char*) const {
        const int row0 = u.pm * BM + wr * 64 + fr; const int col0 = u.pn * BM + wc * 32 + 8 * fq;
#pragma unroll
        for (int ai = 0; ai < 2; ++ai)
#pragma unroll
            for (int m = 0; m < 4; ++m) { bf16_t* rowp = O + (size_t)(row0 + ai * HALF + m * 16) * ldc + col0;
#pragma unroll
                for (int bj = 0; bj < 2; ++bj) { const f32x4 v0 = acc[ai][bj][m][0], v1 = acc[ai][bj][m][1];
                    u32x4 w; w.x = cvt_pk_bf16(v0[0], v0[1]); w.y = cvt_pk_bf16(v0[2], v0[3]); w.z = cvt_pk_bf16(v1[0], v1[1]); w.w = cvt_pk_bf16(v1[2], v1[3]);
                    *(u32x4*)(rowp + bj * HALF) = w; } }
    }
};

template <class Epi, class Sched, bool ALIGN_EPI = false, bool SP2 = false>
__device__ __forceinline__ void gemm_phase(PG8_LAS unsigned char* lds, const Gemm g, const Sched& S, const Epi& E) {
    const int tid = threadIdx.x, wid = __builtin_amdgcn_readfirstlane(tid >> 6), lane = tid & 63, wr = wid >> 2, wc = wid & 3, fr = lane & 15, fq = lane >> 4;
    const int K = g.K, nt = K / BK;
    unsigned voffA[2], voffB[2];
#pragma unroll
    for (int i = 0; i < 2; ++i) { int R, C; stage_rc(tid * 16 + i * 8192, R, C); const int Rb = Epi::PERM ? ((R & ~31) + perm32(R & 31)) : R;
        voffA[i] = (unsigned)(R * K + C) * 2u; voffB[i] = (unsigned)(Rb * K + C) * 2u; }
    const size_t kstep = (size_t)(BK * 2);
    const size_t hstep = (size_t)HALF * K * 2;
    const size_t tstep = 2 * hstep;
    const unsigned ldsw = (unsigned)wid * 1024u;
    const int aoff = lds_byte(wr * 64 + fr, fq * 8), boff = lds_byte(wc * 32 + fr, fq * 8);
#define PG8_SA(b, h) (((b) * 2 + (h)) * HTB)
#define PG8_SB(b, h) ((4 + (b) * 2 + (h)) * HTB)
#define PG8_STAGE(bufoff, gbase, voff) do { _Pragma("unroll") for (int _i = 0; _i < 2; ++_i) \
        __builtin_amdgcn_global_load_lds((const unsigned*)((const char*)(gbase) + (voff)[_i]), (PG8_LAS unsigned*)(lds + (bufoff) + ldsw + _i * 8192), 16, 0, 0); } while (0)
#define PG8_LDA(dst, b, h) do { _Pragma("unroll") for (int m = 0; m < 4; ++m) _Pragma("unroll") for (int k = 0; k < 2; ++k) dst[m][k] = *(const PG8_LAS bf16x8*)(lds + PG8_SA(b, h) + aoff + m * 2048 + k * 1024); } while (0)
#define PG8_LDB(dst, b, h) do { _Pragma("unroll") for (int n = 0; n < 2; ++n) _Pragma("unroll") for (int k = 0; k < 2; ++k) dst[n][k] = *(const PG8_LAS bf16x8*)(lds + PG8_SB(b, h) + boff + n * 2048 + k * 1024); } while (0)
#define PG8_MMA(ai, bj, At, Bt) do { __builtin_amdgcn_s_setprio(1); _Pragma("unroll") for (int m = 0; m < 4; ++m) _Pragma("unroll") for (int n = 0; n < 2; ++n) _Pragma("unroll") for (int k = 0; k < 2; ++k) \
        acc[ai][bj][m][n] = __builtin_amdgcn_mfma_f32_16x16x32_bf16(Bt[n][k], At[m][k], acc[ai][bj][m][n], 0, 0, 0); __builtin_amdgcn_s_setprio(0); } while (0)
#define PG8_WAIT_V(n) asm volatile("s_waitcnt vmcnt(" #n ")" ::: "memory")
#define PG8_WAIT_L(n) asm volatile("s_waitcnt lgkmcnt(" #n ")" ::: "memory")
#define PG8_BAR __builtin_amdgcn_s_barrier()
#define PG8_SCHED __builtin_amdgcn_sched_barrier(0)
    Unit cur, nxt; int ui = 0;
    if (!S.next(0, cur)) return;
    f32x4 acc[2][2][4][2];
#pragma unroll
    for (int a = 0; a < 2; ++a)
#pragma unroll
        for (int b = 0; b < 2; ++b)
#pragma unroll
            for (int m = 0; m < 4; ++m)
#pragma unroll
                for (int n = 0; n < 2; ++n) acc[a][b][m][n] = (f32x4){0.f, 0.f, 0.f, 0.f};
    bf16x8 At[4][2], B0[2][2], B1[2][2];
    const char* cA = (const char*)g.A + (size_t)cur.pm * tstep; const char* cB = (const char*)g.Bt + (size_t)cur.pn * tstep;
    S.a_ready(cur);
    if constexpr (SP2) {
        PG8_STAGE(PG8_SB(0, 0), cB, voffB); PG8_STAGE(PG8_SB(0, 1), cB + hstep, voffB); PG8_STAGE(PG8_SA(0, 0), cA, voffA); PG8_STAGE(PG8_SA(0, 1), cA + hstep, voffA);
        if (wr == 1) PG8_BAR;
        PG8_WAIT_V(2); PG8_BAR;
        PG8_STAGE(PG8_SB(1, 0), cB + kstep, voffB); PG8_STAGE(PG8_SA(1, 0), cA + kstep, voffA); PG8_STAGE(PG8_SB(1, 1), cB + hstep + kstep, voffB);
        PG8_WAIT_V(6); PG8_BAR;
    } else {
        PG8_STAGE(PG8_SB(0, 0), cB, voffB); PG8_STAGE(PG8_SA(0, 0), cA, voffA); PG8_STAGE(PG8_SB(0, 1), cB + hstep, voffB); PG8_STAGE(PG8_SA(0, 1), cA + hstep, voffA);
        if (wr == 1) PG8_BAR;
        PG8_WAIT_V(4); PG8_BAR;
        PG8_STAGE(PG8_SB(1, 0), cB + kstep, voffB); PG8_STAGE(PG8_SA(1, 0), cA + kstep, voffA); PG8_STAGE(PG8_SB(1, 1), cB + hstep + kstep, voffB);
        PG8_WAIT_V(6); PG8_BAR;
    }
    for (;;) {
        const bool has_next = S.next(ui + 1, nxt);
        const char* nA = has_next ? (const char*)g.A + (size_t)nxt.pm * tstep : cA; const char* nB = has_next ? (const char*)g.Bt + (size_t)nxt.pn * tstep : cB;
        for (int t = 0; t < nt; t += 2) {
            const bool last = (t == nt - 2);
            const char* a1 = cA + (size_t)(t + 1) * kstep;
            const char* a2 = last ? nA : cA + (size_t)(t + 2) * kstep; const char* b2 = last ? nB : cB + (size_t)(t + 2) * kstep;
            const char* a3 = a2 + kstep; const char* b3 = b2 + kstep;
            if (last && has_next) S.a_ready(nxt);
            if constexpr (SP2) {
            PG8_LDB(B0, 0, 0); PG8_LDB(B1, 0, 1); PG8_SCHED; PG8_LDA(At, 0, 0); PG8_STAGE(PG8_SA(1, 1), a1 + hstep, voffA);
            PG8_WAIT_V(8); PG8_WAIT_L(0); PG8_BAR; PG8_MMA(0, 0, At, B0); PG8_MMA(0, 1, At, B1); PG8_BAR; PG8_SCHED;
            PG8_LDA(At, 0, 1); PG8_STAGE(PG8_SB(0, 0), b2, voffB); PG8_STAGE(PG8_SB(0, 1), b2 + hstep, voffB); PG8_STAGE(PG8_SA(0, 0), a2, voffA);
            PG8_WAIT_V(8); PG8_WAIT_L(0); PG8_BAR; PG8_MMA(1, 0, At, B0); PG8_MMA(1, 1, At, B1); PG8_BAR; PG8_SCHED;
            PG8_LDB(B0, 1, 0); PG8_LDB(B1, 1, 1); PG8_SCHED; PG8_LDA(At, 1, 0); PG8_STAGE(PG8_SA(0, 1), a2 + hstep, voffA);
            PG8_WAIT_V(8); PG8_WAIT_L(0); PG8_BAR; PG8_MMA(0, 0, At, B0); PG8_MMA(0, 1, At, B1); PG8_BAR; PG8_SCHED;
            PG8_LDA(At, 1, 1); PG8_STAGE(PG8_SB(1, 0), b3, voffB); PG8_STAGE(PG8_SB(1, 1), b3 + hstep, voffB); PG8_STAGE(PG8_SA(1, 0), a3, voffA);
            PG8_WAIT_V(8); PG8_WAIT_L(0); PG8_BAR; PG8_MMA(1, 0, At, B0); PG8_MMA(1, 1, At, B1); PG8_BAR; PG8_SCHED;
            } else {
            PG8_LDB(B0, 0, 0); PG8_SCHED; PG8_LDA(At, 0, 0); PG8_STAGE(PG8_SA(1, 1), a1 + hstep, voffA);
            PG8_WAIT_L(8); PG8_BAR; PG8_WAIT_L(0); PG8_MMA(0, 0, At, B0); PG8_BAR; PG8_SCHED;
            PG8_LDB(B1, 0, 1); PG8_STAGE(PG8_SB(0, 0), b2, voffB);
            PG8_BAR; PG8_WAIT_L(0); PG8_MMA(0, 1, At, B1); PG8_BAR;
            PG8_LDA(At, 0, 1); PG8_STAGE(PG8_SA(0, 0), a2, voffA);
            PG8_BAR; PG8_WAIT_L(0); PG8_MMA(1, 0, At, B0); PG8_BAR; PG8_SCHED;
            PG8_STAGE(PG8_SB(0, 1), b2 + hstep, voffB);
            PG8_WAIT_V(6); PG8_BAR; PG8_MMA(1, 1, At, B1); PG8_BAR;
            PG8_LDB(B0, 1, 0); PG8_SCHED; PG8_LDA(At, 1, 0); PG8_STAGE(PG8_SA(0, 1), a2 + hstep, voffA);
            PG8_WAIT_L(8); PG8_BAR; PG8_WAIT_L(0); PG8_MMA(0, 0, At, B0); PG8_BAR; PG8_SCHED;
            PG8_LDB(B1, 1, 1); PG8_STAGE(PG8_SB(1, 0), b3, voffB);
            PG8_BAR; PG8_WAIT_L(0); PG8_MMA(0, 1, At, B1); PG8_BAR;
            PG8_LDA(At, 1, 1); PG8_STAGE(PG8_SA(1, 0), a3, voffA);
            PG8_BAR; PG8_WAIT_L(0); PG8_MMA(1, 0, At, B0); PG8_BAR; PG8_SCHED;
            PG8_STAGE(PG8_SB(1, 1), b3 + hstep, voffB);
            PG8_WAIT_V(6); PG8_BAR; PG8_MMA(1, 1, At, B1); PG8_BAR;
            }
        }
        if constexpr (ALIGN_EPI) { if (wr == 0) PG8_BAR; }
        E(acc, cur, wr, wc, fr, fq, lds + STAGE_BYTES);
        if (!has_next) break;
#pragma unroll
        for (int a = 0; a < 2; ++a)
#pragma unroll
            for (int b = 0; b < 2; ++b)
#pragma unroll
                for (int m = 0; m < 4; ++m)
#pragma unroll
                    for (int n = 0; n < 2; ++n) acc[a][b][m][n] = (f32x4){0.f, 0.f, 0.f, 0.f};
        cur = nxt; cA = nA; cB = nB; ++ui;
        if constexpr (ALIGN_EPI) { if (wr == 1) PG8_BAR; }
    }
    PG8_WAIT_V(0);
    if constexpr (!ALIGN_EPI) { if (wr == 0) PG8_BAR; }
    PG8_BAR;
#undef PG8_SA
#undef PG8_SB
#undef PG8_STAGE
#undef PG8_LDA
#undef PG8_LDB
#undef PG8_MMA
#undef PG8_WAIT_V
#undef PG8_WAIT_L
#undef PG8_BAR
#undef PG8_SCHED
}
}

constexpr int BATCH = 8, SEQ = 4096, DM = 1024, M = BATCH * SEQ;
constexpr int NPROJ_LOG = 3272, NPROJ = 3328;
constexpr int DFF = 2816, NUP = 2 * DFF;
constexpr float EPS = 1e-6f;
constexpr int NWAVES = 8, NTHREADS = 512;
constexpr int NPHASE = 14;

typedef unsigned short bf16;
typedef float f32x4 __attribute__((ext_vector_type(4)));
typedef unsigned u32x4 __attribute__((ext_vector_type(4)));
typedef unsigned u32x2 __attribute__((ext_vector_type(2)));
#define LAS __attribute__((address_space(3)))

constexpr size_t MiB = 1u << 20;
constexpr size_t WS_CTL = 0;
constexpr size_t WS_COS = 1 * MiB, WS_SIN = WS_COS + 512 * 1024;
constexpr size_t WS_WIN = 2 * MiB;
constexpr size_t WS_WOUT = 9 * MiB;
constexpr size_t WS_WUP = 11 * MiB;
constexpr size_t WS_WDN = 22 * MiB;
constexpr size_t WS_HALO = 28 * MiB;
constexpr size_t WS_PART = 34 * MiB;
constexpr size_t WS_HN = 40 * MiB;
constexpr size_t WS_CAT = WS_HN;
constexpr size_t WS_BA = 104 * MiB;
constexpr size_t WS_BI = 144 * MiB;
constexpr size_t WS_IW = 180 * MiB;
constexpr size_t WS_ST = 181 * MiB;
constexpr size_t WS_PREV = 213 * MiB;
constexpr size_t WS_SEL = 229 * MiB;
constexpr size_t WS_KT = 245 * MiB;
constexpr size_t WS_VT = 277 * MiB;
constexpr size_t WS_HN2 = 309 * MiB;
constexpr size_t WS_BR = 373 * MiB;
constexpr size_t WS_SC = 245 * MiB;
constexpr size_t WS_MIX = 373 * MiB;
constexpr size_t WS_ACT = 104 * MiB;
constexpr size_t WS_FFN = 373 * MiB;
constexpr size_t WS_END = 512 * MiB;
constexpr size_t SC_BATCH = (size_t)128 * 128 * 528;

constexpr int LDS_BYTES = 147456;
constexpr int LDS_XCH = 131072;

__device__ __forceinline__ float bf2f(unsigned u) { return __uint_as_float(u << 16); }
__device__ __forceinline__ float bflo(unsigned w) { return __uint_as_float(w << 16); }
__device__ __forceinline__ float bfhi(unsigned w) { return __uint_as_float(w & 0xffff0000u); }
__device__ __forceinline__ unsigned f2bf(float f) { unsigned u = __float_as_uint(f); return (u + 0x7fffu + ((u >> 16) & 1u)) >> 16; }
__device__ __forceinline__ unsigned pk2(float lo, float hi) { return f2bf(lo) | (f2bf(hi) << 16); }
__device__ __forceinline__ float wave_sum(float v) {
#pragma unroll
    for (int o = 1; o < 64; o <<= 1) v += __shfl_xor(v, o);
    return v;
}
__device__ __forceinline__ float wave_max(float v) {
#pragma unroll
    for (int o = 1; o < 64; o <<= 1) v = fmaxf(v, __shfl_xor(v, o));
    return v;
}
__device__ __forceinline__ int wave_sum_i(int v) {
#pragma unroll
    for (int o = 1; o < 64; o <<= 1) v += __shfl_xor(v, o);
    return v;
}
__device__ __forceinline__ float silu_f(float x) { return x * __builtin_amdgcn_rcpf(1.0f + __builtin_amdgcn_exp2f(-1.4426950408889634f * x)); }
__device__ __forceinline__ float head_lg2(int h) { return log2f(1.0f - exp2f(-5.0f - (float)h)); }

struct Args { const float* in[11]; float* out; unsigned char* ws; int ph_lo, ph_hi, coop, pad; };

struct Frame {
    LAS unsigned char* lds;
    int tid, lane, wave, G, bid;
    const float *x, *g_mix_pre, *g_mix_post, *w_in, *w_out, *g_ffn_pre, *g_ffn_post, *w_up, *conv_w, *conv_b, *w_down;
    float* out; unsigned char* ws;
};

template <class CM>
__device__ __forceinline__ void p0_transpose_item(const float* W, int K, int ldw, int nlog, bf16* WT, LAS float* scr, int kb, int pb, int lane, CM cm) {
    const int k0 = 64 * kb, p0 = 32 * pb; const int q = lane & 31; const int c = cm(p0 + q);
#pragma unroll 8
    for (int i = 0; i < 32; ++i) { const int kk = 2 * i + (lane >> 5); scr[kk * 33 + q] = (c < nlog) ? W[(size_t)(k0 + kk) * ldw + c] : 0.f; }
    asm volatile("s_waitcnt lgkmcnt(0)" ::: "memory");
    const int c8 = lane & 7;
#pragma unroll
    for (int j = 0; j < 4; ++j) { const int n = (lane >> 3) + 8 * j; const LAS float* s = scr + (8 * c8) * 33 + n;
        u32x4 o; o.x = pk2(s[0 * 33], s[1 * 33]); o.y = pk2(s[2 * 33], s[3 * 33]); o.z = pk2(s[4 * 33], s[5 * 33]); o.w = pk2(s[6 * 33], s[7 * 33]);
        *(u32x4*)(WT + (size_t)(p0 + n) * K + k0 + 8 * c8) = o; }
    asm volatile("s_waitcnt lgkmcnt(0)" ::: "memory");
}
struct CmProj { __device__ __forceinline__ int operator()(int P) const { const int G = P >> 5, q = P & 31; return 64 * (G >> 1) + 16 * (G & 1) + (q & 15) + 32 * (q >> 4); } };
struct CmId   { __device__ __forceinline__ int operator()(int P) const { return P; } };
struct CmUp   { __device__ __forceinline__ int operator()(int P) const { return (P >> 8) * 128 + (P & 127) + ((P >> 7) & 1) * DFF; } };

__device__ __forceinline__ void sincos_d(float af, float& s, float& c) {
    const double a = (double)af; const double TWO_PI = 6.283185307179586476925286766559;
    const double n = rint(a * (1.0 / TWO_PI)); const double r = a - n * TWO_PI; const double r2 = r * r;
    double ps = 1.0 / 51090942171709440000.0 * -1.0;
    ps = ps * r2 + 1.0 / 121645100408832000.0;
    ps = ps * r2 - 1.0 / 355687428096000.0;
    ps = ps * r2 + 1.0 / 1307674368000.0;
    ps = ps * r2 - 1.0 / 6227020800.0;
    ps = ps * r2 + 1.0 / 39916800.0;
    ps = ps * r2 - 1.0 / 362880.0;
    ps = ps * r2 + 1.0 / 5040.0;
    ps = ps * r2 - 1.0 / 120.0;
    ps = ps * r2 + 1.0 / 6.0;
    ps = ps * r2 * -1.0 + 1.0;
    double pc = 1.0 / 1124000727777607680000.0;
    pc = pc * r2 - 1.0 / 2432902008176640000.0;
    pc = pc * r2 + 1.0 / 6402373705728000.0;
    pc = pc * r2 - 1.0 / 20922789888000.0;
    pc = pc * r2 + 1.0 / 87178291200.0;
    pc = pc * r2 - 1.0 / 479001600.0;
    pc = pc * r2 + 1.0 / 3628800.0;
    pc = pc * r2 - 1.0 / 40320.0;
    pc = pc * r2 + 1.0 / 720.0;
    pc = pc * r2 - 1.0 / 24.0;
    pc = pc * r2 + 0.5;
    pc = pc * r2 * -1.0 + 1.0;
    s = (float)(r * ps); c = (float)pc;
}

__device__ __forceinline__ void rms_row_to_bf16(const float* xrow, const float* g, bf16* orow, int lane) {
    const f32x4* xr = (const f32x4*)xrow + lane; const f32x4* gr = (const f32x4*)g + lane;
    f32x4 v[4]; float s = 0.f;
#pragma unroll
    for (int j = 0; j < 4; ++j) { v[j] = xr[64 * j]; s += (v[j].x * v[j].x + v[j].y * v[j].y) + (v[j].z * v[j].z + v[j].w * v[j].w); }
    const float rstd = 1.0f / sqrtf(wave_sum(s) * (1.f / DM) + EPS);
    unsigned long long* o8 = (unsigned long long*)orow + lane;
#pragma unroll
    for (int j = 0; j < 4; ++j) { const f32x4 gg = gr[64 * j];
        o8[64 * j] = (unsigned long long)pk2(v[j].x * rstd * gg.x, v[j].y * rstd * gg.y) | ((unsigned long long)pk2(v[j].z * rstd * gg.z, v[j].w * rstd * gg.w) << 32); }
}

__device__ __forceinline__ void phase_prologue(Frame& F) {
    LAS float* scr = (LAS float*)(F.lds + F.wave * 16384);
    const int gw = F.bid * NWAVES + F.wave, NGW = F.G * NWAVES;
    { float* COS = (float*)(F.ws + WS_COS); float* SIN = (float*)(F.ws + WS_SIN);
      for (int i = F.bid * NTHREADS + F.tid; i < SEQ * 32; i += F.G * NTHREADS) { const int pos = i >> 5, j = i & 31;
          const float inv = (float)exp2(-(double)j * (13.287712379549449 / 32.0));
          const float ang = (float)pos * inv; float s, c; sincos_d(ang, s, c); COS[i] = c; SIN[i] = s; } }
    constexpr int I_IN = (DM / 64) * (NPROJ / 32), I_OUT = (DM / 64) * (DM / 32), I_UP = (DM / 64) * (NUP / 32), I_DN = (DFF / 64) * (DM / 32);
    constexpr int NITEMS = I_IN + I_OUT + I_UP + I_DN;
    for (int it = gw; it < NITEMS; it += NGW) {
        int r = it;
        if (r < I_IN) { p0_transpose_item(F.w_in, DM, NPROJ_LOG, NPROJ_LOG, (bf16*)(F.ws + WS_WIN), scr, r / (NPROJ / 32), r % (NPROJ / 32), F.lane, CmProj()); continue; } r -= I_IN;
        if (r < I_OUT) { p0_transpose_item(F.w_out, DM, DM, DM, (bf16*)(F.ws + WS_WOUT), scr, r / (DM / 32), r % (DM / 32), F.lane, CmId()); continue; } r -= I_OUT;
        if (r < I_UP) { p0_transpose_item(F.w_up, DM, NUP, NUP, (bf16*)(F.ws + WS_WUP), scr, r / (NUP / 32), r % (NUP / 32), F.lane, CmUp()); continue; } r -= I_UP;
        p0_transpose_item(F.w_down, DFF, DM, DM, (bf16*)(F.ws + WS_WDN), scr, r / (DM / 32), r % (DM / 32), F.lane, CmId());
    }
    for (int m = gw; m < M; m += NGW) rms_row_to_bf16(F.x + (size_t)m * DM, F.g_mix_pre, (bf16*)(F.ws + WS_HN) + (size_t)m * DM, F.lane);
}

struct EpiProj {
    static constexpr bool PERM = false, AFTER_DRAIN = false;
    unsigned char* ws;
    __device__ __forceinline__ void operator()(const pg8::f32x4 (&acc)[2][2][4][2], const pg8::Unit& u, int wr, int wc, int fr, int fq, PG8_LAS unsigned char*) const {
        const float* COS = (const float*)(ws + WS_COS); const float* SIN = (const float*)(ws + WS_SIN);
        const int half = wc & 1, d0 = 16 * half + 4 * fq;
#pragma unroll
        for (int bj = 0; bj < 2; ++bj) {
            const int hb = 4 * u.pn + 2 * bj + (wc >> 1);
            if (hb >= 52) continue;
            const bool rope = (hb < 16) || (hb >= 32 && hb <= 40) || (hb >= 42 && hb <= 50);
            const float sc = ((hb >= 8 && hb < 16) || (hb >= 32 && hb < 40)) ? 0.125f : 1.0f;
            bf16* dst; int ld, col;
            if (hb < 32) { dst = (bf16*)(ws + WS_BR); ld = 2048; col = hb * 64; }
            else if (hb < 42) { dst = (bf16*)(ws + WS_BA); ld = 640; col = (hb - 32) * 64; }
            else { dst = (bf16*)(ws + WS_BI); ld = 576; col = (hb - 42) * 64; }
            bf16* tdst = nullptr;
            if (hb >= 8 && hb < 16) tdst = (bf16*)(ws + WS_KT) + (size_t)(hb - 8) * 64 * SEQ;
            if (hb >= 16 && hb < 24) tdst = (bf16*)(ws + WS_VT) + (size_t)(hb - 16) * 64 * SEQ;
#pragma unroll
            for (int ai = 0; ai < 2; ++ai)
#pragma unroll
                for (int m = 0; m < 4; ++m) {
                    const int row = u.pm * 256 + ai * 128 + wr * 64 + m * 16 + fr; const int pos = row & (SEQ - 1);
                    f32x4 v0 = acc[ai][bj][m][0], v1 = acc[ai][bj][m][1];
                    if (hb == 51) {
                        if (half == 0 && fq < 2) { float* iw = (float*)(ws + WS_IW) + (size_t)row * 8 + 4 * fq; *(f32x4*)iw = v0 * 0.044194173824159216f; }
                        continue;
                    }
                    if (rope) { const f32x4 cs = *(const f32x4*)(COS + pos * 32 + d0), sn = *(const f32x4*)(SIN + pos * 32 + d0);
                        const f32x4 o0 = v0 * cs - v1 * sn, o1 = v1 * cs + v0 * sn; v0 = o0 * sc; v1 = o1 * sc; }
                    u32x2 w0, w1; w0.x = pk2(v0[0], v0[1]); w0.y = pk2(v0[2], v0[3]); w1.x = pk2(v1[0], v1[1]); w1.y = pk2(v1[2], v1[3]);
                    bf16* p = dst + (size_t)row * ld + col + d0;
                    *(u32x2*)p = w0; *(u32x2*)(p + 32) = w1;
                    if (tdst) { bf16* tp = tdst + (size_t)(row >> 12) * (8 * 64 * SEQ) + (size_t)d0 * SEQ + pos;
                        tp[0 * SEQ] = (bf16)(w0.x & 0xffff); tp[1 * SEQ] = (bf16)(w0.x >> 16); tp[2 * SEQ] = (bf16)(w0.y & 0xffff); tp[3 * SEQ] = (bf16)(w0.y >> 16);
                        tp += 32 * SEQ;
                        tp[0 * SEQ] = (bf16)(w1.x & 0xffff); tp[1 * SEQ] = (bf16)(w1.x >> 16); tp[2 * SEQ] = (bf16)(w1.y & 0xffff); tp[3 * SEQ] = (bf16)(w1.y >> 16); }
                }
        }
    }
};

__device__ __forceinline__ void phase_ret_state(Frame& F) {
    const bf16* KT = (const bf16*)(F.ws + WS_KT); const bf16* VT = (const bf16*)(F.ws + WS_VT); float* ST = (float*)(F.ws + WS_ST);
    const int total = 2048 * 4096;
    for (int o = F.bid * NTHREADS + F.tid; o < total; o += F.G * NTHREADS) {
        const int unit = o >> 12, v = (o >> 6) & 63, k = o & 63, b = unit >> 8, n = (unit >> 3) & 31, h = unit & 7;
        const float lg = head_lg2(h);
        const u32x4* vp = (const u32x4*)(VT + ((size_t)((b * 8 + h) * 64 + v)) * SEQ + n * 128);
        const u32x4* kp = (const u32x4*)(KT + ((size_t)((b * 8 + h) * 64 + k)) * SEQ + n * 128);
        float acc = 0.f;
        for (int m8 = 0; m8 < 16; ++m8) { const u32x4 a = vp[m8], c = kp[m8];
#pragma unroll
            for (int j = 0; j < 4; ++j) { const int m = m8 * 8 + 2 * j;
                acc += bflo(a[j]) * bflo(c[j]) * exp2f(lg * (float)(127 - m)); acc += bfhi(a[j]) * bfhi(c[j]) * exp2f(lg * (float)(126 - m)); } }
        ST[o] = acc;
    }
}
__device__ __forceinline__ void phase_ret_scan(Frame& F) {
    const float* ST = (const float*)(F.ws + WS_ST); bf16* PV = (bf16*)(F.ws + WS_PREV);
    for (int e = F.bid * NTHREADS + F.tid; e < 8 * 8 * 4096; e += F.G * NTHREADS) {
        const int b = e >> 15, h = (e >> 12) & 7, vk = e & 4095; const float dec = exp2f(128.0f * head_lg2(h)); float R = 0.f;
        for (int n = 0; n < 32; ++n) { const size_t idx = ((size_t)((b * 32 + n) * 8 + h) << 12) + vk; PV[idx] = (bf16)f2bf(R); R = dec * R + ST[idx]; }
    }
}
__device__ __forceinline__ void phase_ret_out(Frame& F) {
    const bf16* BR = (const bf16*)(F.ws + WS_BR); const bf16* PV = (const bf16*)(F.ws + WS_PREV); bf16* CAT = (bf16*)(F.ws + WS_CAT);
    const int gw = F.bid * NWAVES + F.wave, NGW = F.G * NWAVES, lane = F.lane;
    for (int row = gw; row < M * 8; row += NGW) {
        const int tok = row >> 3, h = row & 7, t = tok & (SEQ - 1), n = t >> 7, c = t & 127, r0 = tok - c, b = tok >> 12;
        const float lg = head_lg2(h);
        float q[64];
        { const u32x4* qp = (const u32x4*)(BR + (size_t)tok * 2048 + h * 64);
#pragma unroll
          for (int i = 0; i < 8; ++i) { const u32x4 w = qp[i];
#pragma unroll
              for (int j = 0; j < 4; ++j) { q[i * 8 + 2 * j] = bflo(w[j]); q[i * 8 + 2 * j + 1] = bfhi(w[j]); } } }
        float s_lo = 0.f, s_hi = 0.f;
#pragma unroll
        for (int part = 0; part < 2; ++part) { const int m = lane + 64 * part;
            if (m <= c) { const u32x4* kp = (const u32x4*)(BR + (size_t)(r0 + m) * 2048 + 512 + h * 64); float d = 0.f;
#pragma unroll
                for (int i = 0; i < 8; ++i) { const u32x4 w = kp[i];
#pragma unroll
                    for (int j = 0; j < 4; ++j) { d += q[i * 8 + 2 * j] * bflo(w[j]); d += q[i * 8 + 2 * j + 1] * bfhi(w[j]); } }
                d *= exp2f(lg * (float)(c - m)); if (part == 0) s_lo = d; else s_hi = d; } }
        float o = 0.f;
        for (int m = 0; m <= c; ++m) { const float sm = __shfl(m < 64 ? s_lo : s_hi, m & 63); o += sm * bf2f(BR[(size_t)(r0 + m) * 2048 + 1024 + h * 64 + lane]); }
        { const int unit = (b * 32 + n) * 8 + h; const u32x4* pp = (const u32x4*)(PV + ((size_t)unit << 12) + lane * 64); float cr = 0.f;
#pragma unroll
          for (int i = 0; i < 8; ++i) { const u32x4 w = pp[i];
#pragma unroll
              for (int j = 0; j < 4; ++j) { cr += q[i * 8 + 2 * j] * bflo(w[j]); cr += q[i * 8 + 2 * j + 1] * bfhi(w[j]); } }
          o += cr * exp2f(lg * (float)(c + 1)); }
        const float ss = wave_sum(o * o); o *= 1.0f / sqrtf(ss * (1.f / 64.f) + EPS);
        const float g = bf2f(BR[(size_t)tok * 2048 + 1536 + h * 64 + lane]); o *= silu_f(g);
        CAT[(size_t)tok * 1024 + h * 64 + lane] = (bf16)f2bf(o);
    }
}
__device__ __forceinline__ size_t sc_off(int b, int qb) { return (size_t)b * SC_BATCH + (size_t)16384 * (size_t)(qb * (qb + 1) / 2); }
__device__ __forceinline__ void phase_idx_scores(Frame& F) {
    const bf16* BI = (const bf16*)(F.ws + WS_BI); const float* IW = (const float*)(F.ws + WS_IW); float* SC = (float*)(F.ws + WS_SC);
    const int gw = F.bid * NWAVES + F.wave, NGW = F.G * NWAVES, lane = F.lane;
    for (int task = gw; task < 8 * 1056; task += NGW) {
        const int b = task & 7; int r = task >> 3; int qb = 0; while (r >= 2 * (qb + 1)) { r -= 2 * (qb + 1); ++qb; } const int kc = r;
        const int s = kc * 64 + lane; const int pitch = (qb + 1) * 128;
        unsigned kr[32];
        { const u32x4* kp = (const u32x4*)(BI + (size_t)(b * SEQ + s) * 576 + 512);
#pragma unroll
          for (int i = 0; i < 8; ++i) { const u32x4 w = kp[i]; kr[4 * i] = w.x; kr[4 * i + 1] = w.y; kr[4 * i + 2] = w.z; kr[4 * i + 3] = w.w; } }
        float* scb = SC + sc_off(b, qb) + s;
        for (int tq = 0; tq < 128; ++tq) { const int tok = b * SEQ + qb * 128 + tq; float sc = 0.f;
            const f32x4 w0 = *(const f32x4*)(IW + (size_t)tok * 8), w1 = *(const f32x4*)(IW + (size_t)tok * 8 + 4);
#pragma unroll
            for (int h = 0; h < 8; ++h) { const u32x4* qp = (const u32x4*)(BI + (size_t)tok * 576 + h * 64); float d = 0.f;
#pragma unroll
                for (int i = 0; i < 8; ++i) { const u32x4 w = qp[i];
#pragma unroll
                    for (int j = 0; j < 4; ++j) { d += bflo(w[j]) * bflo(kr[4 * i + j]); d += bfhi(w[j]) * bfhi(kr[4 * i + j]); } }
                const float wh = h < 4 ? w0[h & 3] : w1[h & 3]; sc += wh * fmaxf(d, 0.f); }
            scb[(size_t)tq * pitch] = sc; }
    }
}
__device__ __forceinline__ void phase_select(Frame& F) {
    const float* SC = (const float*)(F.ws + WS_SC); bf16* SEL = (bf16*)(F.ws + WS_SEL);
    const int gw = F.bid * NWAVES + F.wave, NGW = F.G * NWAVES, lane = F.lane;
    const unsigned long long lt = (1ull << lane) - 1ull;
    for (int tok = gw; tok < M; tok += NGW) {
        const int t = tok & (SEQ - 1), b = tok >> 12; if (t < 256) continue;
        const int L = t + 1, qb = t >> 7, pitch = (qb + 1) * 128;
        const float* rowp = SC + sc_off(b, qb) + (size_t)(t & 127) * pitch;
        unsigned u[64];
#pragma unroll
        for (int j = 0; j < 64; ++j) { u[j] = 0u; if (64 * j < L) { const int s = 64 * j + lane; const float f = rowp[s]; unsigned bits = __float_as_uint(f); if (f == 0.f) bits = 0u;
            const unsigned key = (bits & 0x80000000u) ? ~bits : (bits | 0x80000000u); u[j] = (s < L) ? key : 0u; } }
        unsigned T = 0u;
        for (int bit = 31; bit >= 0; --bit) { const unsigned cand = T | (1u << bit); int cnt = 0;
#pragma unroll
            for (int j = 0; j < 64; ++j) cnt += (u[j] >= cand) ? 1 : 0;
            cnt = wave_sum_i(cnt); if (cnt >= 256) T = cand; }
        int ngt = 0;
#pragma unroll
        for (int j = 0; j < 64; ++j) ngt += (u[j] > T) ? 1 : 0;
        ngt = wave_sum_i(ngt); const int need_eq = 256 - ngt;
        int pos = 0, eqc = 0; bf16* out = SEL + (size_t)tok * 256;
#pragma unroll
        for (int j = 0; j < 64; ++j) { if (64 * j < L) {
            const bool gt = u[j] > T, eq = u[j] == T; const unsigned long long meq = __ballot(eq);
            const bool take = gt || (eq && (eqc + __popcll(meq & lt)) < need_eq); const unsigned long long mt = __ballot(take);
            if (take) out[pos + __popcll(mt & lt)] = (bf16)(64 * j + lane);
            pos += __popcll(mt); eqc += __popcll(meq); } }
    }
}
__device__ __forceinline__ void phase_attn(Frame& F) {
    const bf16* BA = (const bf16*)(F.ws + WS_BA); const bf16* SEL = (const bf16*)(F.ws + WS_SEL); bf16* CAT = (bf16*)(F.ws + WS_CAT);
    const int gw = F.bid * NWAVES + F.wave, NGW = F.G * NWAVES, lane = F.lane;
    LAS float* pl = (LAS float*)(F.lds + F.wave * 16384);
    LAS int* il = (LAS int*)(F.lds + F.wave * 16384 + 8192);
    for (int tok = gw; tok < M; tok += NGW) {
        const int t = tok & (SEQ - 1), b = tok >> 12; const int nk = t + 1 < 256 ? t + 1 : 256;
        float lg[8][4]; int idx[4];
#pragma unroll
        for (int i = 0; i < 4; ++i) { const int j = lane + 64 * i; idx[i] = (t < 256) ? (j < nk ? j : 0) : (int)SEL[(size_t)tok * 256 + j];
            unsigned kr[32]; { const u32x4* kp = (const u32x4*)(BA + (size_t)(b * SEQ + idx[i]) * 640 + 512);
#pragma unroll
                for (int c = 0; c < 8; ++c) { const u32x4 w = kp[c]; kr[4 * c] = w.x; kr[4 * c + 1] = w.y; kr[4 * c + 2] = w.z; kr[4 * c + 3] = w.w; } }
#pragma unroll
            for (int h = 0; h < 8; ++h) { const u32x4* qp = (const u32x4*)(BA + (size_t)tok * 640 + h * 64); float d = 0.f;
#pragma unroll
                for (int c = 0; c < 8; ++c) { const u32x4 w = qp[c];
#pragma unroll
                    for (int e = 0; e < 4; ++e) { d += bflo(w[e]) * bflo(kr[4 * c + e]); d += bfhi(w[e]) * bfhi(kr[4 * c + e]); } }
                lg[h][i] = (j < nk) ? d : -1e30f; } }
#pragma unroll
        for (int h = 0; h < 8; ++h) { float mx = fmaxf(fmaxf(lg[h][0], lg[h][1]), fmaxf(lg[h][2], lg[h][3])); mx = wave_max(mx); float e[4], sm = 0.f;
#pragma unroll
            for (int i = 0; i < 4; ++i) { e[i] = (lane + 64 * i < nk) ? __expf(lg[h][i] - mx) : 0.f; sm += e[i]; }
            sm = wave_sum(sm); const float inv = 1.0f / sm;
#pragma unroll
            for (int i = 0; i < 4; ++i) pl[(lane + 64 * i) * 8 + h] = e[i] * inv; }
#pragma unroll
        for (int i = 0; i < 4; ++i) il[lane + 64 * i] = idx[i];
        asm volatile("s_waitcnt lgkmcnt(0)" ::: "memory");
        float o[8];
#pragma unroll
        for (int h = 0; h < 8; ++h) o[h] = 0.f;
        for (int j = 0; j < nk; ++j) { const int kidx = il[j]; const float v = bf2f(BA[(size_t)(b * SEQ + kidx) * 640 + 576 + lane]);
            const f32x4 p0 = *(const LAS f32x4*)(pl + j * 8), p1 = *(const LAS f32x4*)(pl + j * 8 + 4);
            o[0] += p0.x * v; o[1] += p0.y * v; o[2] += p0.z * v; o[3] += p0.w * v; o[4] += p1.x * v; o[5] += p1.y * v; o[6] += p1.z * v; o[7] += p1.w * v; }
#pragma unroll
        for (int h = 0; h < 8; ++h) CAT[(size_t)tok * 1024 + 512 + h * 64 + lane] = (bf16)f2bf(o[h]);
        asm volatile("s_waitcnt lgkmcnt(0)" ::: "memory");
    }
}

__device__ __forceinline__ void phase_norm1(Frame& F) {
    const bf16* MIX = (const bf16*)(F.ws + WS_MIX); bf16* HN2 = (bf16*)(F.ws + WS_HN2);
    const int gw = F.bid * NWAVES + F.wave, NGW = F.G * NWAVES, lane = F.lane;
    for (int m = gw; m < M; m += NGW) {
        const u32x2* mr = (const u32x2*)(MIX + (size_t)m * DM) + lane; const f32x4* xr = (const f32x4*)(F.x + (size_t)m * DM) + lane;
        const f32x4* g1 = (const f32x4*)F.g_mix_post + lane; const f32x4* g2 = (const f32x4*)F.g_ffn_pre + lane;
        f32x4 v[4]; float s = 0.f;
#pragma unroll
        for (int j = 0; j < 4; ++j) { const u32x2 w = mr[64 * j]; v[j] = (f32x4){bflo(w.x), bfhi(w.x), bflo(w.y), bfhi(w.y)}; s += (v[j].x * v[j].x + v[j].y * v[j].y) + (v[j].z * v[j].z + v[j].w * v[j].w); }
        const float rstd = 1.0f / sqrtf(wave_sum(s) * (1.f / DM) + EPS); float s2 = 0.f;
        f32x4* orow = (f32x4*)(F.out + (size_t)m * DM) + lane;
#pragma unroll
        for (int j = 0; j < 4; ++j) { v[j] = xr[64 * j] + v[j] * rstd * g1[64 * j]; orow[64 * j] = v[j]; s2 += (v[j].x * v[j].x + v[j].y * v[j].y) + (v[j].z * v[j].z + v[j].w * v[j].w); }
        const float rstd2 = 1.0f / sqrtf(wave_sum(s2) * (1.f / DM) + EPS);
        unsigned long long* o8 = (unsigned long long*)(HN2 + (size_t)m * DM) + lane;
#pragma unroll
        for (int j = 0; j < 4; ++j) { const f32x4 gg = g2[64 * j];
            o8[64 * j] = (unsigned long long)pk2(v[j].x * rstd2 * gg.x, v[j].y * rstd2 * gg.y) | ((unsigned long long)pk2(v[j].z * rstd2 * gg.z, v[j].w * rstd2 * gg.w) << 32); }
    }
}
__device__ __forceinline__ void phase_norm2(Frame& F) {
    const bf16* FFN = (const bf16*)(F.ws + WS_FFN);
    const int gw = F.bid * NWAVES + F.wave, NGW = F.G * NWAVES, lane = F.lane;
    for (int m = gw; m < M; m += NGW) {
        const u32x2* mr = (const u32x2*)(FFN + (size_t)m * DM) + lane; const f32x4* g1 = (const f32x4*)F.g_ffn_post + lane;
        f32x4 v[4]; float s = 0.f;
#pragma unroll
        for (int j = 0; j < 4; ++j) { const u32x2 w = mr[64 * j]; v[j] = (f32x4){bflo(w.x), bfhi(w.x), bflo(w.y), bfhi(w.y)}; s += (v[j].x * v[j].x + v[j].y * v[j].y) + (v[j].z * v[j].z + v[j].w * v[j].w); }
        const float rstd = 1.0f / sqrtf(wave_sum(s) * (1.f / DM) + EPS);
        f32x4* orow = (f32x4*)(F.out + (size_t)m * DM) + lane;
#pragma unroll
        for (int j = 0; j < 4; ++j) orow[64 * j] = orow[64 * j] + v[j] * rstd * g1[64 * j];
    }
}

__device__ __forceinline__ float dpp_shr1(float old, float src) { return __int_as_float(__builtin_amdgcn_update_dpp(__float_as_int(old), __float_as_int(src), 0x111, 0xf, 0xf, false)); }
__device__ __forceinline__ float dpp_shr2(float old, float src) { return __int_as_float(__builtin_amdgcn_update_dpp(__float_as_int(old), __float_as_int(src), 0x112, 0xf, 0xf, false)); }
__device__ __forceinline__ float dpp_ror1(float src) { return __int_as_float(__builtin_amdgcn_update_dpp(0, __float_as_int(src), 0x121, 0xf, 0xf, false)); }
__device__ __forceinline__ float dpp_ror2(float src) { return __int_as_float(__builtin_amdgcn_update_dpp(0, __float_as_int(src), 0x122, 0xf, 0xf, false)); }
struct EpiUp {
    static constexpr bool PERM = true, AFTER_DRAIN = false;
    unsigned char* ws; const float* conv_w; const float* conv_b;
    __device__ __forceinline__ void operator()(const pg8::f32x4 (&acc)[2][2][4][2], const pg8::Unit& u, int wr, int wc, int fr, int fq, PG8_LAS unsigned char* xl) const {
        PG8_LAS float* X = (PG8_LAS float*)xl;
        const int cl = 32 * wc + 8 * fq;
        if (fr >= 14) {
#pragma unroll
            for (int ai = 0; ai < 2; ++ai)
#pragma unroll
                for (int bj = 0; bj < 2; ++bj)
#pragma unroll
                    for (int n = 0; n < 2; ++n) *(PG8_LAS f32x4*)(X + ((ai * 2 + wr) * 2 + (fr - 14)) * 256 + bj * 128 + cl + 4 * n) = acc[ai][bj][3][n];
            if (wr == 1) { float* H = (float*)(ws + WS_HALO) + ((size_t)(u.pm * 22 + u.pn) * 2 + (fr - 14)) * 256;
#pragma unroll
                for (int bj = 0; bj < 2; ++bj)
#pragma unroll
                    for (int n = 0; n < 2; ++n) *(f32x4*)(H + bj * 128 + cl + 4 * n) = acc[1][bj][3][n]; }
        }
        asm volatile("s_waitcnt lgkmcnt(0)" ::: "memory"); __builtin_amdgcn_s_barrier(); asm volatile("" ::: "memory");
        const bool seq_start = (u.pm & 15) == 0;
        bf16* ACT = (bf16*)(ws + WS_ACT);
#pragma unroll
        for (int n = 0; n < 2; ++n) {
            f32x4 w0[2], w1[2], w2[2], bb[2];
#pragma unroll
            for (int bj = 0; bj < 2; ++bj) { const int ch = bj * DFF + 128 * u.pn + cl + 4 * n;
                w0[bj] = *(const f32x4*)(conv_w + ch); w1[bj] = *(const f32x4*)(conv_w + NUP + ch); w2[bj] = *(const f32x4*)(conv_w + 2 * NUP + ch); bb[bj] = *(const f32x4*)(conv_b + ch); }
#pragma unroll
            for (int ai = 0; ai < 2; ++ai) {
                const bool has_pred = !(ai == 0 && wr == 0);
                const int pai = (wr == 1) ? ai : 0, pwr = (wr == 1) ? 0 : 1;
#pragma unroll
                for (int m = 0; m < 4; ++m) {
                    f32x4 y[2];
#pragma unroll
                    for (int bj = 0; bj < 2; ++bj) {
                        const f32x4 cur = acc[ai][bj][m][n]; f32x4 p1, p2;
                        if (m == 0) {
                            f32x4 x0 = (f32x4){0.f, 0.f, 0.f, 0.f}, x1 = x0;
                            if (has_pred) { const PG8_LAS float* xp = X + ((pai * 2 + pwr) * 2) * 256 + bj * 128 + cl + 4 * n; x0 = *(const PG8_LAS f32x4*)xp; x1 = *(const PG8_LAS f32x4*)(xp + 256); }
                            const f32x4 o2 = (fr == 0) ? x0 : x1;
#pragma unroll
                            for (int e = 0; e < 4; ++e) { p1[e] = dpp_shr1(x1[e], cur[e]); p2[e] = dpp_shr2(o2[e], cur[e]); }
                        } else {
                            const f32x4 prv = acc[ai][bj][m > 0 ? m - 1 : 0][n];
#pragma unroll
                            for (int e = 0; e < 4; ++e) { p1[e] = dpp_shr1(dpp_ror1(prv[e]), cur[e]); p2[e] = dpp_shr2(dpp_ror2(prv[e]), cur[e]); }
                        }
                        y[bj] = bb[bj] + w2[bj] * cur + w1[bj] * p1 + w0[bj] * p2;
                    }
                    const int row = u.pm * 256 + ai * 128 + wr * 64 + m * 16 + fr;
                    const bool partial = (ai == 0 && wr == 0 && m == 0 && fr < 2 && !seq_start);
                    if (partial) { float* P = (float*)(ws + WS_PART) + ((size_t)(u.pm * 22 + u.pn) * 2 + fr) * 256 + cl + 4 * n; *(f32x4*)P = y[0]; *(f32x4*)(P + 128) = y[1]; }
                    else { f32x4 a;
#pragma unroll
                        for (int e = 0; e < 4; ++e) a[e] = silu_f(y[0][e]) * y[1][e];
                        u32x2 pk; pk.x = pk2(a[0], a[1]); pk.y = pk2(a[2], a[3]);
                        *(u32x2*)(ACT + (size_t)row * DFF + 128 * u.pn + cl + 4 * n) = pk; }
                    asm volatile("" ::: "memory");
                }
            }
        }
    }
};
__device__ __forceinline__ void phase_fixup(Frame& F) {
    const float* H = (const float*)(F.ws + WS_HALO); const float* P = (const float*)(F.ws + WS_PART); bf16* ACT = (bf16*)(F.ws + WS_ACT);
    const int total = 128 * 22 * 2 * 128;
    for (int i = F.bid * NTHREADS + F.tid; i < total; i += F.G * NTHREADS) {
        const int c = i & 127, j = (i >> 7) & 1, pn = (i >> 8) % 22, pm = (i >> 8) / 22;
        if ((pm & 15) == 0) continue;
        const float* pp = P + ((size_t)(pm * 22 + pn) * 2 + j) * 256; const float* hp = H + ((size_t)((pm - 1) * 22 + pn) * 2) * 256;
        float y[2];
#pragma unroll
        for (int bj = 0; bj < 2; ++bj) { const int ch = bj * DFF + 128 * pn + c; const float w0 = F.conv_w[ch], w1 = F.conv_w[NUP + ch];
            const float h0 = hp[bj * 128 + c], h1 = hp[256 + bj * 128 + c];
            y[bj] = pp[bj * 128 + c] + (j == 0 ? (w1 * h1 + w0 * h0) : (w0 * h1)); }
        ACT[(size_t)(pm * 256 + j) * DFF + 128 * pn + c] = (bf16)f2bf(silu_f(y[0]) * y[1]);
    }
}

__global__ void __launch_bounds__(NTHREADS, 2) hymba_fwd(Args args) {
    extern __shared__ __attribute__((aligned(16))) unsigned char lds_raw[];
    Frame F;
    F.lds = (LAS unsigned char*)lds_raw;
    F.tid = threadIdx.x; F.lane = F.tid & 63; F.wave = __builtin_amdgcn_readfirstlane(F.tid >> 6); F.G = gridDim.x; F.bid = blockIdx.x;
    F.x = args.in[0]; F.g_mix_pre = args.in[1]; F.g_mix_post = args.in[2]; F.w_in = args.in[3]; F.w_out = args.in[4]; F.g_ffn_pre = args.in[5]; F.g_ffn_post = args.in[6];
    F.w_up = args.in[7]; F.conv_w = args.in[8]; F.conv_b = args.in[9]; F.w_down = args.in[10]; F.out = args.out; F.ws = args.ws;
    const int lo = args.ph_lo, hi = args.ph_hi;
    cg::grid_group grid = cg::this_grid();
#define IN(k) (lo <= (k) && (k) < hi)
#define SEAM(k) do { if (IN(k) && IN((k) + 1)) { if (args.coop) grid.sync(); } } while (0)
    if (IN(0)) { phase_prologue(F); } SEAM(0);
    if (IN(1)) { pg8::Gemm g{(const bf16*)(F.ws + WS_HN), (const bf16*)(F.ws + WS_WIN), M, NPROJ, DM}; pg8::StaticOrder S; S.init(M, NPROJ, F.G, F.bid);
        EpiProj E{F.ws}; pg8::gemm_phase<EpiProj, pg8::StaticOrder, true, true>(F.lds, g, S, E); } SEAM(1);
    if (IN(2)) { phase_ret_state(F); } SEAM(2);
    if (IN(3)) { phase_ret_scan(F); } SEAM(3);
    if (IN(4)) { phase_ret_out(F); } SEAM(4);
    if (IN(5)) { phase_idx_scores(F); } SEAM(5);
    if (IN(6)) { phase_select(F); } SEAM(6);
    if (IN(7)) { phase_attn(F); } SEAM(7);
    if (IN(8)) { pg8::Gemm g{(const bf16*)(F.ws + WS_CAT), (const bf16*)(F.ws + WS_WOUT), M, DM, DM}; pg8::StaticOrder S; S.init(M, DM, F.G, F.bid);
        pg8::EpiStore E{(bf16*)(F.ws + WS_MIX), DM}; pg8::gemm_phase<pg8::EpiStore, pg8::StaticOrder, true, true>(F.lds, g, S, E); } SEAM(8);
    if (IN(9)) { phase_norm1(F); } SEAM(9);
    if (IN(10)) { pg8::Gemm g{(const bf16*)(F.ws + WS_HN2), (const bf16*)(F.ws + WS_WUP), M, NUP, DM}; pg8::StaticOrder S; S.init(M, NUP, F.G, F.bid);
        EpiUp E{F.ws, F.conv_w, F.conv_b}; pg8::gemm_phase<EpiUp, pg8::StaticOrder, true, true>(F.lds, g, S, E); } SEAM(10);
    if (IN(11)) { phase_fixup(F); } SEAM(11);
    if (IN(12)) { pg8::Gemm g{(const bf16*)(F.ws + WS_ACT), (const bf16*)(F.ws + WS_WDN), M, DM, DFF}; pg8::StaticOrder S; S.init(M, DM, F.G, F.bid);
        pg8::EpiStore E{(bf16*)(F.ws + WS_FFN), DM}; pg8::gemm_phase<pg8::EpiStore, pg8::StaticOrder, true, true>(F.lds, g, S, E); } SEAM(12);
    if (IN(13)) { phase_norm2(F); }
#undef IN
#undef SEAM
}

extern "C" void kernel_launch(void* const* d_in, const int* in_sizes, int n_in, void* d_out, int out_size, void* d_ws, size_t ws_size, hipStream_t stream) {
    static int grid = 0;
    if (grid == 0) {
        if (n_in != 11 || in_sizes[0] != M * DM || out_size != M * DM || ws_size < WS_END) { fprintf(stderr, "kernel_launch: unexpected shapes (n_in %d, in0 %d, out %d, ws %zu)\n", n_in, n_in > 0 ? in_sizes[0] : -1, out_size, ws_size); grid = -1; return; }
        int dev = 0, cus = 0, per_cu = 0;
        hipGetDevice(&dev); hipDeviceGetAttribute(&cus, hipDeviceAttributeMultiprocessorCount, dev);
        hipFuncSetAttribute((const void*)hymba_fwd, hipFuncAttributeMaxDynamicSharedMemorySize, LDS_BYTES);
        hipOccupancyMaxActiveBlocksPerMultiprocessor(&per_cu, (const void*)hymba_fwd, NTHREADS, LDS_BYTES);
        if (per_cu < 1) { fprintf(stderr, "kernel_launch: occupancy query says %d blocks per CU\n", per_cu); per_cu = 1; }
        (void)hipGetLastError();
        grid = cus * 1;
    }
    if (grid < 0) return;
    Args a{};
    for (int i = 0; i < 11; ++i) a.in[i] = (const float*)d_in[i];
    a.out = (float*)d_out; a.ws = (unsigned char*)d_ws;
#if MK_MULTI
    for (int p = 0; p < NPHASE; ++p) { a.ph_lo = p; a.ph_hi = p + 1; a.coop = 0; hipLaunchKernelGGL(hymba_fwd, dim3(grid), dim3(NTHREADS), LDS_BYTES, stream, a); }
#else
    a.ph_lo = 0; a.ph_hi = NPHASE; a.coop = 1;
    void* kargs[] = {&a};
    hipError_t e = hipLaunchCooperativeKernel((const void*)hymba_fwd, dim3(grid), dim3(NTHREADS), kargs, LDS_BYTES, stream);
    if (e != hipSuccess) fprintf(stderr, "cooperative launch failed: %s (grid %d)\n", hipGetErrorString(e), grid);
#endif
}
```

```cpp
#include <hip/hip_runtime.h>
#include <hip/hip_cooperative_groups.h>
#include <cstdio>
#include <cstdint>
namespace cg = cooperative_groups;

#ifndef MK_MULTI
#define MK_MULTI 0
#endif

namespace pg8 {
#define PG8_LAS __attribute__((address_space(3)))
typedef unsigned short bf16_t;
typedef short bf16x8 __attribute__((ext_vector_type(8)));
typedef float f32x4 __attribute__((ext_vector_type(4)));
typedef unsigned u32x4 __attribute__((ext_vector_type(4)));
typedef unsigned u32x2 __attribute__((ext_vector_type(2)));
constexpr int BM = 256, BK = 64, HALF = 128, HTB = HALF * BK * 2, STAGE_BYTES = 8 * HTB, NXCD = 8, WGM = 8;

__host__ __device__ __forceinline__ int lds_byte(int r, int c) { const int st = (r >> 4) * 2 + (c >> 5), rr = r & 15, cc = c & 31, ob = rr * 64 + cc * 2; return st * 1024 + (ob ^ (((ob >> 9) & 1) << 5)); }
__host__ __device__ __forceinline__ void stage_rc(int b, int& R, int& C) { const int st = b / 1024, sb = b % 1024, swz = sb ^ (((sb >> 9) & 1) << 5); R = (st >> 1) * 16 + swz / 64; C = (st & 1) * 32 + (swz % 64) / 2; }
__host__ __device__ __forceinline__ int perm32(int rho) { const int n = rho >> 4, i = rho & 15; return 8 * (i >> 2) + 4 * n + (i & 3); }

struct Unit { int pm, pn; };
struct Gemm { const bf16_t* A; const bf16_t* Bt; int M, N, K; };

struct StaticOrder {
    int nM, nN, nwg, G, c;
    __host__ __device__ void init(int M, int N, int G_, int c_) { nM = M / BM; nN = N / BM; nwg = nM * nN; G = G_; c = c_; }
    __host__ __device__ bool next(int i, Unit& u) const {
        const long L = (long)i * G + c; if (L >= nwg) return false;
        int wgid = (int)L; { const int q = nwg / NXCD, r = nwg % NXCD, xcd = wgid % NXCD, off = wgid / NXCD; wgid = (xcd < r ? xcd * (q + 1) : r * (q + 1) + (xcd - r) * q) + off; }
        const int nig = WGM * nN, gid = wgid / nig, fm = gid * WGM, gsz = (nM - fm) < WGM ? (nM - fm) : WGM;
        u.pm = fm + ((wgid % nig) % gsz); u.pn = (wgid % nig) / gsz; return true;
    }
    __device__ __forceinline__ void a_ready(const Unit&) const {}
    __device__ __forceinline__ void done(const Unit&) const {}
};

__device__ __forceinline__ unsigned cvt_pk_bf16(float lo, float hi) { unsigned r; asm volatile("v_cvt_pk_bf16_f32 %0, %1, %2" : "=v"(r) : "v"(lo), "v"(hi)); return r; }

struct EpiStore {
    static constexpr bool PERM = true, AFTER_DRAIN = false, NEEDS_LDS = false;
    bf16_t* O; int ldc;
    __device__ __forceinline__ void operator()(const f32x4 (&acc)[2][2][4][2], const Unit& u, int wr, int wc, int fr, int fq, PG8_LAS unsigned char*) const {
        const int row0 = u.pm * BM + wr * 64 + fr; const int col0 = u.pn * BM + wc * 32 + 8 * fq;
#pragma unroll
        for (int ai = 0; ai < 2; ++ai)
#pragma unroll
            for (int m = 0; m < 4; ++m) { bf16_t* rowp = O + (size_t)(row0 + ai * HALF + m * 16) * ldc + col0;
#pragma unroll
                for (int bj = 0; bj < 2; ++bj) { const f32x4 v0 = acc[ai][bj][m][0], v1 = acc[ai][bj][m][1];
                    u32x4 w; w.x = cvt_pk_bf16(v0[0], v0[1]); w.y = cvt_pk_bf16(v0[2], v0[3]); w.z = cvt_pk_bf16(v1[0], v1[1]); w.w = cvt_pk_bf16(v1[2], v1[3]);
                    *(u32x4*)(rowp + bj * HALF) = w; } }
    }
};

template <class Epi, class Sched, bool ALIGN_EPI = false, bool SP2 = false>
__device__ __forceinline__ void gemm_phase(PG8_LAS unsigned char* lds, const Gemm g, const Sched& S, const Epi& E) {
    const int tid = threadIdx.x, wid = __builtin_amdgcn_readfirstlane(tid >> 6), lane = tid & 63, wr = wid >> 2, wc = wid & 3, fr = lane & 15, fq = lane >> 4;
    const int K = g.K, nt = K / BK;
    unsigned voffA[2], voffB[2];
#pragma unroll
    for (int i = 0; i < 2; ++i) { int R, C; stage_rc(tid * 16 + i * 8192, R, C); const int Rb = Epi::PERM ? ((R & ~31) + perm32(R & 31)) : R;
        voffA[i] = (unsigned)(R * K + C) * 2u; voffB[i] = (unsigned)(Rb * K + C) * 2u; }
    const size_t kstep = (size_t)(BK * 2);
    const size_t hstep = (size_t)HALF * K * 2;
    const size_t tstep = 2 * hstep;
    const unsigned ldsw = (unsigned)wid * 1024u;
    const int aoff = lds_byte(wr * 64 + fr, fq * 8), boff = lds_byte(wc * 32 + fr, fq * 8);
#define PG8_SA(b, h) (((b) * 2 + (h)) * HTB)
#define PG8_SB(b, h) ((4 + (b) * 2 + (h)) * HTB)
#define PG8_STAGE(bufoff, gbase, voff) do { _Pragma("unroll") for (int _i = 0; _i < 2; ++_i) \
        __builtin_amdgcn_global_load_lds((const unsigned*)((const char*)(gbase) + (voff)[_i]), (PG8_LAS unsigned*)(lds + (bufoff) + ldsw + _i * 8192), 16, 0, 0); } while (0)
#define PG8_LDA(dst, b, h) do { _Pragma("unroll") for (int m = 0; m < 4; ++m) _Pragma("unroll") for (int k = 0; k < 2; ++k) dst[m][k] = *(const PG8_LAS bf16x8*)(lds + PG8_SA(b, h) + aoff + m * 2048 + k * 1024); } while (0)
#define PG8_LDB(dst, b, h) do { _Pragma("unroll") for (int n = 0; n < 2; ++n) _Pragma("unroll") for (int k = 0; k < 2; ++k) dst[n][k] = *(const PG8_LAS bf16x8*)(lds + PG8_SB(b, h) + boff + n * 2048 + k * 1024); } while (0)
#define PG8_MMA(ai, bj, At, Bt) do { __builtin_amdgcn_s_setprio(1); _Pragma("unroll") for (int m = 0; m < 4; ++m) _Pragma("unroll") for (int n = 0; n < 2; ++n) _Pragma("unroll") for (int k = 0; k < 2; ++k) \
        acc[ai][bj][m][n] = __builtin_amdgcn_mfma_f32_16x16x32_bf16(Bt[n][k], At[m][k], acc[ai][bj][m][n], 0, 0, 0); __builtin_amdgcn_s_setprio(0); } while (0)
#define PG8_WAIT_V(n) asm volatile("s_waitcnt vmcnt(" #n ")" ::: "memory")
#define PG8_WAIT_L(n) asm volatile("s_waitcnt lgkmcnt(" #n ")" ::: "memory")
#define PG8_BAR __builtin_amdgcn_s_barrier()
#define PG8_SCHED __builtin_amdgcn_sched_barrier(0)
    Unit cur, nxt; int ui = 0;
    if (!S.next(0, cur)) return;
    f32x4 acc[2][2][4][2];
#pragma unroll
    for (int a = 0; a < 2; ++a)
#pragma unroll
        for (int b = 0; b < 2; ++b)
#pragma unroll
            for (int m = 0; m < 4; ++m)
#pragma unroll
                for (int n = 0; n < 2; ++n) acc[a][b][m][n] = (f32x4){0.f, 0.f, 0.f, 0.f};
    bf16x8 At[4][2], B0[2][2], B1[2][2];
    const char* cA = (const char*)g.A + (size_t)cur.pm * tstep; const char* cB = (const char*)g.Bt + (size_t)cur.pn * tstep;
    S.a_ready(cur);
    if constexpr (SP2) {
        PG8_STAGE(PG8_SB(0, 0), cB, voffB); PG8_STAGE(PG8_SB(0, 1), cB + hstep, voffB); PG8_STAGE(PG8_SA(0, 0), cA, voffA); PG8_STAGE(PG8_SA(0, 1), cA + hstep, voffA);
        if (wr == 1) PG8_BAR;
        PG8_WAIT_V(2); PG8_BAR;
        PG8_STAGE(PG8_SB(1, 0), cB + kstep, voffB); PG8_STAGE(PG8_SA(1, 0), cA + kstep, voffA); PG8_STAGE(PG8_SB(1, 1), cB + hstep + kstep, voffB);
        PG8_WAIT_V(6); PG8_BAR;
    } else {
        PG8_STAGE(PG8_SB(0, 0), cB, voffB); PG8_STAGE(PG8_SA(0, 0), cA, voffA); PG8_STAGE(PG8_SB(0, 1), cB + hstep, voffB); PG8_STAGE(PG8_SA(0, 1), cA + hstep, voffA);
        if (wr == 1) PG8_BAR;
        PG8_WAIT_V(4); PG8_BAR;
        PG8_STAGE(PG8_SB(1, 0), cB + kstep, voffB); PG8_STAGE(PG8_SA(1, 0), cA + kstep, voffA); PG8_STAGE(PG8_SB(1, 1), cB + hstep + kstep, voffB);
        PG8_WAIT_V(6); PG8_BAR;
    }
    for (;;) {
        const bool has_next = S.next(ui + 1, nxt);
        const char* nA = has_next ? (const char*)g.A + (size_t)nxt.pm * tstep : cA; const char* nB = has_next ? (const char*)g.Bt + (size_t)nxt.pn * tstep : cB;
        for (int t = 0; t < nt; t += 2) {
            const bool last = (t == nt - 2);
            const char* a1 = cA + (size_t)(t + 1) * kstep;
            const char* a2 = last ? nA : cA + (size_t)(t + 2) * kstep; const char* b2 = last ? nB : cB + (size_t)(t + 2) * kstep;
            const char* a3 = a2 + kstep; const char* b3 = b2 + kstep;
            if (last && has_next) S.a_ready(nxt);
            if constexpr (SP2) {
            PG8_LDB(B0, 0, 0); PG8_LDB(B1, 0, 1); PG8_SCHED; PG8_LDA(At, 0, 0); PG8_STAGE(PG8_SA(1, 1), a1 + hstep, voffA);
            PG8_WAIT_V(8); PG8_WAIT_L(0); PG8_BAR; PG8_MMA(0, 0, At, B0); PG8_MMA(0, 1, At, B1); PG8_BAR; PG8_SCHED;
            PG8_LDA(At, 0, 1); PG8_STAGE(PG8_SB(0, 0), b2, voffB); PG8_STAGE(PG8_SB(0, 1), b2 + hstep, voffB); PG8_STAGE(PG8_SA(0, 0), a2, voffA);
            PG8_WAIT_V(8); PG8_WAIT_L(0); PG8_BAR; PG8_MMA(1, 0, At, B0); PG8_MMA(1, 1, At, B1); PG8_BAR; PG8_SCHED;
            PG8_LDB(B0, 1, 0); PG8_LDB(B1, 1, 1); PG8_SCHED; PG8_LDA(At, 1, 0); PG8_STAGE(PG8_SA(0, 1), a2 + hstep, voffA);
            PG8_WAIT_V(8); PG8_WAIT_L(0); PG8_BAR; PG8_MMA(0, 0, At, B0); PG8_MMA(0, 1, At, B1); PG8_BAR; PG8_SCHED;
            PG8_LDA(At, 1, 1); PG8_STAGE(PG8_SB(1, 0), b3, voffB); PG8_STAGE(PG8_SB(1, 1), b3 + hstep, voffB); PG8_STAGE(PG8_SA(1, 0), a3, voffA);
            PG8_WAIT_V(8); PG8_WAIT_L(0); PG8_BAR; PG8_MMA(1, 0, At, B0); PG8_MMA(1, 1, At, B1); PG8_BAR; PG8_SCHED;
            } else {
            PG8_LDB(B0, 0, 0); PG8_SCHED; PG8_LDA(At, 0, 0); PG8_STAGE(PG8_SA(1, 1), a1 + hstep, voffA);
            PG8_WAIT_L(8); PG8_BAR; PG8_WAIT_L(0); PG8_MMA(0, 0, At, B0); PG8_BAR; PG8_SCHED;
            PG8_LDB(B1, 0, 1); PG8_STAGE(PG8_SB(0, 0), b2, voffB);
            PG8_BAR; PG8_WAIT_L(0); PG8_MMA(0, 1, At, B1); PG8_BAR;
            PG8_LDA(At, 0, 1); PG8_STAGE(PG8_SA(0, 0), a2, voffA);
            PG8_BAR; PG8_WAIT_L(0); PG8_MMA(1, 0, At, B0); PG8_BAR; PG8_SCHED;
            PG8_STAGE(PG8_SB(0, 1), b2 + hstep, voffB);
            PG8_WAIT_V(6); PG8_BAR; PG8_MMA(1, 1, At, B1); PG8_BAR;
            PG8_LDB(B0, 1, 0); PG8_SCHED; PG8_LDA(At, 1, 0); PG8_STAGE(PG8_SA(0, 1), a2 + hstep, voffA);
            PG8_WAIT_L(8); PG8_BAR; PG8_WAIT_L(0); PG8_MMA(0, 0, At, B0); PG8_BAR; PG8_SCHED;
            PG8_LDB(B1, 1, 1); PG8_STAGE(PG8_SB(1, 0), b3, voffB);
            PG8_BAR; PG8_WAIT_L(0); PG8_MMA(0, 1, At, B1); PG8_BAR;
            PG8_LDA(At, 1, 1); PG8_STAGE(PG8_SA(1, 0), a3, voffA);
            PG8_BAR; PG8_WAIT_L(0); PG8_MMA(1, 0, At, B0); PG8_BAR; PG8_SCHED;
            PG8_STAGE(PG8_SB(1, 1), b3 + hstep, voffB);
            PG8_WAIT_V(6); PG8_BAR; PG8_MMA(1, 1, At, B1); PG8_BAR;
            }
        }
        if constexpr (ALIGN_EPI) { if (wr == 0) PG8_BAR; }
        E(acc, cur, wr, wc, fr, fq, lds + STAGE_BYTES);
        if (!has_next) break;
#pragma unroll
        for (int a = 0; a < 2; ++a)
#pragma unroll
            for (int b = 0; b < 2; ++b)
#pragma unroll
                for (int m = 0; m < 4; ++m)
#pragma unroll
                    for (int n = 0; n < 2; ++n) acc[a][b][m][n] = (f32x4){0.f, 0.f, 0.f, 0.f};
        cur = nxt; cA = nA; cB = nB; ++ui;
        if constexpr (ALIGN_EPI) { if (wr == 1) PG8_BAR; }
    }
    PG8_WAIT_V(0);
    if constexpr (!ALIGN_EPI) { if (wr == 0) PG8_BAR; }
    PG8_BAR;
#undef PG8_SA
#undef PG8_SB
#undef PG8_STAGE
#undef PG8_LDA
#undef PG8_LDB
#undef PG8_MMA
#undef PG8_WAIT_V
#undef PG8_WAIT_L
#undef PG8_BAR
#undef PG8_SCHED
}
}

constexpr int BATCH = 8, SEQ = 4096, DM = 1024, M = BATCH * SEQ;
constexpr int NPROJ_LOG = 3272, NPROJ = 3328;
constexpr int DFF = 2816, NUP = 2 * DFF;
constexpr float EPS = 1e-6f;
constexpr int NWAVES = 8, NTHREADS = 512;
constexpr int NPHASE = 14;

typedef unsigned short bf16;
typedef float f32x4 __attribute__((ext_vector_type(4)));
typedef unsigned u32x4 __attribute__((ext_vector_type(4)));
typedef unsigned u32x2 __attribute__((ext_vector_type(2)));
#define LAS __attribute__((address_space(3)))
typedef short bf16x8_t __attribute__((ext_vector_type(8)));
typedef float f32x16 __attribute__((ext_vector_type(16)));
typedef short v4i16_t __attribute__((ext_vector_type(4)));

constexpr size_t MiB = 1u << 20;
constexpr size_t WS_CTL = 0;
constexpr size_t WS_COS = 1 * MiB, WS_SIN = WS_COS + 512 * 1024;
constexpr size_t WS_WIN = 2 * MiB;
constexpr size_t WS_WOUT = 9 * MiB;
constexpr size_t WS_WUP = 11 * MiB;
constexpr size_t WS_WDN = 22 * MiB;
constexpr size_t WS_HALO = 28 * MiB;
constexpr size_t WS_PART = 34 * MiB;
constexpr size_t WS_HN = 40 * MiB;
constexpr size_t WS_CAT = WS_HN;
constexpr size_t WS_BA = 104 * MiB;
constexpr size_t WS_BI = 144 * MiB;
constexpr size_t WS_IW = 180 * MiB;
constexpr size_t WS_ST = 181 * MiB;
constexpr size_t WS_PREV = 213 * MiB;
constexpr size_t WS_SEL = 229 * MiB;
constexpr size_t WS_KT = 245 * MiB;
constexpr size_t WS_VT = 277 * MiB;
constexpr size_t WS_HN2 = 309 * MiB;
constexpr size_t WS_BR = 373 * MiB;
constexpr size_t WS_SC = 245 * MiB;
constexpr size_t WS_MIX = 373 * MiB;
constexpr size_t WS_ACT = 104 * MiB;
constexpr size_t WS_FFN = 373 * MiB;
constexpr size_t WS_END = 512 * MiB;
constexpr size_t SC_BATCH = (size_t)128 * 128 * 528;

constexpr int LDS_BYTES = 147456;
constexpr int LDS_XCH = 131072;

__device__ __forceinline__ float bf2f(unsigned u) { return __uint_as_float(u << 16); }
__device__ __forceinline__ float bflo(unsigned w) { return __uint_as_float(w << 16); }
__device__ __forceinline__ float bfhi(unsigned w) { return __uint_as_float(w & 0xffff0000u); }
__device__ __forceinline__ unsigned f2bf(float f) { unsigned u = __float_as_uint(f); return (u + 0x7fffu + ((u >> 16) & 1u)) >> 16; }
__device__ __forceinline__ unsigned pk2(float lo, float hi) { return f2bf(lo) | (f2bf(hi) << 16); }
__device__ __forceinline__ float wave_sum(float v) {
#pragma unroll
    for (int o = 1; o < 64; o <<= 1) v += __shfl_xor(v, o);
    return v;
}
__device__ __forceinline__ float wave_max(float v) {
#pragma unroll
    for (int o = 1; o < 64; o <<= 1) v = fmaxf(v, __shfl_xor(v, o));
    return v;
}
__device__ __forceinline__ int wave_sum_i(int v) {
#pragma unroll
    for (int o = 1; o < 64; o <<= 1) v += __shfl_xor(v, o);
    return v;
}
__device__ __forceinline__ float silu_f(float x) { return x * __builtin_amdgcn_rcpf(1.0f + __builtin_amdgcn_exp2f(-1.4426950408889634f * x)); }
__device__ __forceinline__ float head_lg2(int h) { return log2f(1.0f - exp2f(-5.0f - (float)h)); }

struct Args { const float* in[11]; float* out; unsigned char* ws; int ph_lo, ph_hi, coop, pad; };

struct Frame {
    LAS unsigned char* lds;
    int tid, lane, wave, G, bid;
    const float *x, *g_mix_pre, *g_mix_post, *w_in, *w_out, *g_ffn_pre, *g_ffn_post, *w_up, *conv_w, *conv_b, *w_down;
    float* out; unsigned char* ws;
};

template <class CM>
__device__ __forceinline__ void p0_transpose_item(const float* W, int K, int ldw, int nlog, bf16* WT, LAS float* scr, int kb, int pb, int lane, CM cm) {
    const int k0 = 64 * kb, p0 = 32 * pb; const int q = lane & 31; const int c = cm(p0 + q);
#pragma unroll 8
    for (int i = 0; i < 32; ++i) { const int kk = 2 * i + (lane >> 5); scr[kk * 33 + q] = (c < nlog) ? W[(size_t)(k0 + kk) * ldw + c] : 0.f; }
    asm volatile("s_waitcnt lgkmcnt(0)" ::: "memory");
    const int c8 = lane & 7;
#pragma unroll
    for (int j = 0; j < 4; ++j) { const int n = (lane >> 3) + 8 * j; const LAS float* s = scr + (8 * c8) * 33 + n;
        u32x4 o; o.x = pk2(s[0 * 33], s[1 * 33]); o.y = pk2(s[2 * 33], s[3 * 33]); o.z = pk2(s[4 * 33], s[5 * 33]); o.w = pk2(s[6 * 33], s[7 * 33]);
        *(u32x4*)(WT + (size_t)(p0 + n) * K + k0 + 8 * c8) = o; }
    asm volatile("s_waitcnt lgkmcnt(0)" ::: "memory");
}
struct CmProj { __device__ __forceinline__ int operator()(int P) const { const int G = P >> 5, q = P & 31; return 64 * (G >> 1) + 16 * (G & 1) + (q & 15) + 32 * (q >> 4); } };
struct CmId   { __device__ __forceinline__ int operator()(int P) const { return P; } };
struct CmUp   { __device__ __forceinline__ int operator()(int P) const { return (P >> 8) * 128 + (P & 127) + ((P >> 7) & 1) * DFF; } };

__device__ __forceinline__ void sincos_d(float af, float& s, float& c) {
    const double a = (double)af; const double TWO_PI = 6.283185307179586476925286766559;
    const double n = rint(a * (1.0 / TWO_PI)); const double r = a - n * TWO_PI; const double r2 = r * r;
    double ps = 1.0 / 51090942171709440000.0 * -1.0;
    ps = ps * r2 + 1.0 / 121645100408832000.0;
    ps = ps * r2 - 1.0 / 355687428096000.0;
    ps = ps * r2 + 1.0 / 1307674368000.0;
    ps = ps * r2 - 1.0 / 6227020800.0;
    ps = ps * r2 + 1.0 / 39916800.0;
    ps = ps * r2 - 1.0 / 362880.0;
    ps = ps * r2 + 1.0 / 5040.0;
    ps = ps * r2 - 1.0 / 120.0;
    ps = ps * r2 + 1.0 / 6.0;
    ps = ps * r2 * -1.0 + 1.0;
    double pc = 1.0 / 1124000727777607680000.0;
    pc = pc * r2 - 1.0 / 2432902008176640000.0;
    pc = pc * r2 + 1.0 / 6402373705728000.0;
    pc = pc * r2 - 1.0 / 20922789888000.0;
    pc = pc * r2 + 1.0 / 87178291200.0;
    pc = pc * r2 - 1.0 / 479001600.0;
    pc = pc * r2 + 1.0 / 3628800.0;
    pc = pc * r2 - 1.0 / 40320.0;
    pc = pc * r2 + 1.0 / 720.0;
    pc = pc * r2 - 1.0 / 24.0;
    pc = pc * r2 + 0.5;
    pc = pc * r2 * -1.0 + 1.0;
    s = (float)(r * ps); c = (float)pc;
}

__device__ __forceinline__ void rms_row_to_bf16(const float* xrow, const float* g, bf16* orow, int lane) {
    const f32x4* xr = (const f32x4*)xrow + lane; const f32x4* gr = (const f32x4*)g + lane;
    f32x4 v[4]; float s = 0.f;
#pragma unroll
    for (int j = 0; j < 4; ++j) { v[j] = xr[64 * j]; s += (v[j].x * v[j].x + v[j].y * v[j].y) + (v[j].z * v[j].z + v[j].w * v[j].w); }
    const float rstd = 1.0f / sqrtf(wave_sum(s) * (1.f / DM) + EPS);
    unsigned long long* o8 = (unsigned long long*)orow + lane;
#pragma unroll
    for (int j = 0; j < 4; ++j) { const f32x4 gg = gr[64 * j];
        o8[64 * j] = (unsigned long long)pk2(v[j].x * rstd * gg.x, v[j].y * rstd * gg.y) | ((unsigned long long)pk2(v[j].z * rstd * gg.z, v[j].w * rstd * gg.w) << 32); }
}

__device__ __forceinline__ void phase_prologue(Frame& F) {
    LAS float* scr = (LAS float*)(F.lds + F.wave * 16384);
    const int gw = F.bid * NWAVES + F.wave, NGW = F.G * NWAVES;
    { float* COS = (float*)(F.ws + WS_COS); float* SIN = (float*)(F.ws + WS_SIN);
      for (int i = F.bid * NTHREADS + F.tid; i < SEQ * 32; i += F.G * NTHREADS) { const int pos = i >> 5, j = i & 31;
          const float inv = (float)exp2(-(double)j * (13.287712379549449 / 32.0));
          const float ang = (float)pos * inv; float s, c; sincos_d(ang, s, c); COS[i] = c; SIN[i] = s; } }
    constexpr int I_IN = (DM / 64) * (NPROJ / 32), I_OUT = (DM / 64) * (DM / 32), I_UP = (DM / 64) * (NUP / 32), I_DN = (DFF / 64) * (DM / 32);
    constexpr int NITEMS = I_IN + I_OUT + I_UP + I_DN;
    for (int it = gw; it < NITEMS; it += NGW) {
        int r = it;
        if (r < I_IN) { p0_transpose_item(F.w_in, DM, NPROJ_LOG, NPROJ_LOG, (bf16*)(F.ws + WS_WIN), scr, r / (NPROJ / 32), r % (NPROJ / 32), F.lane, CmProj()); continue; } r -= I_IN;
        if (r < I_OUT) { p0_transpose_item(F.w_out, DM, DM, DM, (bf16*)(F.ws + WS_WOUT), scr, r / (DM / 32), r % (DM / 32), F.lane, CmId()); continue; } r -= I_OUT;
        if (r < I_UP) { p0_transpose_item(F.w_up, DM, NUP, NUP, (bf16*)(F.ws + WS_WUP), scr, r / (NUP / 32), r % (NUP / 32), F.lane, CmUp()); continue; } r -= I_UP;
        p0_transpose_item(F.w_down, DFF, DM, DM, (bf16*)(F.ws + WS_WDN), scr, r / (DM / 32), r % (DM / 32), F.lane, CmId());
    }
    for (int m = gw; m < M; m += NGW) rms_row_to_bf16(F.x + (size_t)m * DM, F.g_mix_pre, (bf16*)(F.ws + WS_HN) + (size_t)m * DM, F.lane);
}

struct EpiProj {
    static constexpr bool PERM = false, AFTER_DRAIN = false;
    unsigned char* ws;
    __device__ __forceinline__ void operator()(const pg8::f32x4 (&acc)[2][2][4][2], const pg8::Unit& u, int wr, int wc, int fr, int fq, PG8_LAS unsigned char*) const {
        const float* COS = (const float*)(ws + WS_COS); const float* SIN = (const float*)(ws + WS_SIN);
        const int half = wc & 1, d0 = 16 * half + 4 * fq;
#pragma unroll
        for (int bj = 0; bj < 2; ++bj) {
            const int hb = 4 * u.pn + 2 * bj + (wc >> 1);
            if (hb >= 52) continue;
            const bool rope = (hb < 16) || (hb >= 32 && hb <= 40) || (hb >= 42 && hb <= 50);
            const float sc = ((hb >= 8 && hb < 16) || (hb >= 32 && hb < 40)) ? 0.125f : 1.0f;
            bf16* dst; int ld, col;
            if (hb < 32) { dst = (bf16*)(ws + WS_BR); ld = 2048; col = hb * 64; }
            else if (hb < 42) { dst = (bf16*)(ws + WS_BA); ld = 640; col = (hb - 32) * 64; }
            else { dst = (bf16*)(ws + WS_BI); ld = 576; col = (hb - 42) * 64; }
            bf16* tdst = nullptr;
            if (hb >= 8 && hb < 16) tdst = (bf16*)(ws + WS_KT) + (size_t)(hb - 8) * 64 * SEQ;
            if (hb >= 16 && hb < 24) tdst = (bf16*)(ws + WS_VT) + (size_t)(hb - 16) * 64 * SEQ;
#pragma unroll
            for (int ai = 0; ai < 2; ++ai)
#pragma unroll
                for (int m = 0; m < 4; ++m) {
                    const int row = u.pm * 256 + ai * 128 + wr * 64 + m * 16 + fr; const int pos = row & (SEQ - 1);
                    f32x4 v0 = acc[ai][bj][m][0], v1 = acc[ai][bj][m][1];
                    if (hb == 51) {
                        if (half == 0 && fq < 2) { float* iw = (float*)(ws + WS_IW) + (size_t)row * 8 + 4 * fq; *(f32x4*)iw = v0 * 0.044194173824159216f; }
                        continue;
                    }
                    if (rope) { const f32x4 cs = *(const f32x4*)(COS + pos * 32 + d0), sn = *(const f32x4*)(SIN + pos * 32 + d0);
                        const f32x4 o0 = v0 * cs - v1 * sn, o1 = v1 * cs + v0 * sn; v0 = o0 * sc; v1 = o1 * sc; }
                    u32x2 w0, w1; w0.x = pk2(v0[0], v0[1]); w0.y = pk2(v0[2], v0[3]); w1.x = pk2(v1[0], v1[1]); w1.y = pk2(v1[2], v1[3]);
                    bf16* p = dst + (size_t)row * ld + col + d0;
                    *(u32x2*)p = w0; *(u32x2*)(p + 32) = w1;
                    if (tdst) { bf16* tp = tdst + (size_t)(row >> 12) * (8 * 64 * SEQ) + (size_t)d0 * SEQ + pos;
                        const float zf = (hb < 16) ? exp2f(head_lg2(hb - 8) * (float)(127 - (pos & 127))) : 1.0f;
#pragma unroll
                        for (int e = 0; e < 4; ++e) { tp[e * SEQ] = (bf16)f2bf(v0[e] * zf); tp[(32 + e) * SEQ] = (bf16)f2bf(v1[e] * zf); } }
                }
        }
    }
};

__device__ __forceinline__ void phase_ret_state(Frame& F) {
    const bf16* KT = (const bf16*)(F.ws + WS_KT); const bf16* VT = (const bf16*)(F.ws + WS_VT); float* ST = (float*)(F.ws + WS_ST);
    const int total = 2048 * 4096;
    for (int o = F.bid * NTHREADS + F.tid; o < total; o += F.G * NTHREADS) {
        const int unit = o >> 12, v = (o >> 6) & 63, k = o & 63, b = unit >> 8, n = (unit >> 3) & 31, h = unit & 7;
        const float lg = head_lg2(h);
        const u32x4* vp = (const u32x4*)(VT + ((size_t)((b * 8 + h) * 64 + v)) * SEQ + n * 128);
        const u32x4* kp = (const u32x4*)(KT + ((size_t)((b * 8 + h) * 64 + k)) * SEQ + n * 128);
        float acc = 0.f;
        for (int m8 = 0; m8 < 16; ++m8) { const u32x4 a = vp[m8], c = kp[m8];
#pragma unroll
            for (int j = 0; j < 4; ++j) { const int m = m8 * 8 + 2 * j;
                acc += bflo(a[j]) * bflo(c[j]) * exp2f(lg * (float)(127 - m)); acc += bfhi(a[j]) * bfhi(c[j]) * exp2f(lg * (float)(126 - m)); } }
        ST[o] = acc;
    }
}
__device__ __forceinline__ void phase_ret_scan(Frame& F) {
    const float* ST = (const float*)(F.ws + WS_ST); bf16* PV = (bf16*)(F.ws + WS_PREV);
    for (int e = F.bid * NTHREADS + F.tid; e < 8 * 8 * 4096; e += F.G * NTHREADS) {
        const int b = e >> 15, h = (e >> 12) & 7, vk = e & 4095; const float dec = exp2f(128.0f * head_lg2(h)); float R = 0.f;
        for (int n = 0; n < 32; ++n) { const size_t idx = ((size_t)((b * 32 + n) * 8 + h) << 12) + vk; PV[idx] = (bf16)f2bf(R); R = dec * R + ST[idx]; }
    }
}
__device__ __forceinline__ void phase_ret_out(Frame& F) {
    const bf16* BR = (const bf16*)(F.ws + WS_BR); const bf16* PV = (const bf16*)(F.ws + WS_PREV); bf16* CAT = (bf16*)(F.ws + WS_CAT);
    const int gw = F.bid * NWAVES + F.wave, NGW = F.G * NWAVES, lane = F.lane;
    for (int row = gw; row < M * 8; row += NGW) {
        const int tok = row >> 3, h = row & 7, t = tok & (SEQ - 1), n = t >> 7, c = t & 127, r0 = tok - c, b = tok >> 12;
        const float lg = head_lg2(h);
        float q[64];
        { const u32x4* qp = (const u32x4*)(BR + (size_t)tok * 2048 + h * 64);
#pragma unroll
          for (int i = 0; i < 8; ++i) { const u32x4 w = qp[i];
#pragma unroll
              for (int j = 0; j < 4; ++j) { q[i * 8 + 2 * j] = bflo(w[j]); q[i * 8 + 2 * j + 1] = bfhi(w[j]); } } }
        float s_lo = 0.f, s_hi = 0.f;
#pragma unroll
        for (int part = 0; part < 2; ++part) { const int m = lane + 64 * part;
            if (m <= c) { const u32x4* kp = (const u32x4*)(BR + (size_t)(r0 + m) * 2048 + 512 + h * 64); float d = 0.f;
#pragma unroll
                for (int i = 0; i < 8; ++i) { const u32x4 w = kp[i];
#pragma unroll
                    for (int j = 0; j < 4; ++j) { d += q[i * 8 + 2 * j] * bflo(w[j]); d += q[i * 8 + 2 * j + 1] * bfhi(w[j]); } }
                d *= exp2f(lg * (float)(c - m)); if (part == 0) s_lo = d; else s_hi = d; } }
        float o = 0.f;
        for (int m = 0; m <= c; ++m) { const float sm = __shfl(m < 64 ? s_lo : s_hi, m & 63); o += sm * bf2f(BR[(size_t)(r0 + m) * 2048 + 1024 + h * 64 + lane]); }
        { const int unit = (b * 32 + n) * 8 + h; const u32x4* pp = (const u32x4*)(PV + ((size_t)unit << 12) + lane * 64); float cr = 0.f;
#pragma unroll
          for (int i = 0; i < 8; ++i) { const u32x4 w = pp[i];
#pragma unroll
              for (int j = 0; j < 4; ++j) { cr += q[i * 8 + 2 * j] * bflo(w[j]); cr += q[i * 8 + 2 * j + 1] * bfhi(w[j]); } }
          o += cr * exp2f(lg * (float)(c + 1)); }
        const float ss = wave_sum(o * o); o *= 1.0f / sqrtf(ss * (1.f / 64.f) + EPS);
        const float g = bf2f(BR[(size_t)tok * 2048 + 1536 + h * 64 + lane]); o *= silu_f(g);
        CAT[(size_t)tok * 1024 + h * 64 + lane] = (bf16)f2bf(o);
    }
}
__device__ __forceinline__ void phase_ret_state_mfma(Frame& F) {
    const bf16* KT = (const bf16*)(F.ws + WS_KT); const bf16* VT = (const bf16*)(F.ws + WS_VT); float* ST = (float*)(F.ws + WS_ST);
    const int gw = F.bid * NWAVES + F.wave, NGW = F.G * NWAVES, lane = F.lane, r = lane & 31, hh = lane >> 5;
    for (int unit = gw; unit < 2048; unit += NGW) {
        const int b = unit >> 8, n = (unit >> 3) & 31, h = unit & 7;
        const bf16* vp = VT + ((size_t)((b * 8 + h) * 64 + r)) * SEQ + n * 128 + 8 * hh;
        const bf16* kp = KT + ((size_t)((b * 8 + h) * 64 + r)) * SEQ + n * 128 + 8 * hh;
        f32x16 acc[2][2];
#pragma unroll
        for (int a = 0; a < 2; ++a)
#pragma unroll
            for (int c = 0; c < 2; ++c)
#pragma unroll
                for (int i = 0; i < 16; ++i) acc[a][c][i] = 0.f;
#pragma unroll
        for (int s = 0; s < 8; ++s) {
            bf16x8_t va[2], kb[2];
#pragma unroll
            for (int x = 0; x < 2; ++x) { va[x] = *(const bf16x8_t*)(vp + (size_t)32 * x * SEQ + 16 * s); kb[x] = *(const bf16x8_t*)(kp + (size_t)32 * x * SEQ + 16 * s); }
#pragma unroll
            for (int a = 0; a < 2; ++a)
#pragma unroll
                for (int c = 0; c < 2; ++c) acc[a][c] = __builtin_amdgcn_mfma_f32_32x32x16_bf16(va[a], kb[c], acc[a][c], 0, 0, 0);
        }
        float* o = ST + ((size_t)unit << 12);
#pragma unroll
        for (int a = 0; a < 2; ++a)
#pragma unroll
            for (int c = 0; c < 2; ++c)
#pragma unroll
                for (int i = 0; i < 16; ++i) o[(32 * a + (i & 3) + 8 * (i >> 2) + 4 * hh) * 64 + 32 * c + r] = acc[a][c][i];
    }
}
__device__ __forceinline__ void phase_ret_out_mfma(Frame& F) {
    const bf16* BR = (const bf16*)(F.ws + WS_BR); const bf16* VT = (const bf16*)(F.ws + WS_VT); const bf16* PV = (const bf16*)(F.ws + WS_PREV); bf16* CAT = (bf16*)(F.ws + WS_CAT);
    const int gw = F.bid * NWAVES + F.wave, NGW = F.G * NWAVES, lane = F.lane, r = lane & 31, hh = lane >> 5;
    for (int unit = gw; unit < 2048; unit += NGW) {
        const int b = unit >> 8, n = (unit >> 3) & 31, h = unit & 7; const int r0 = b * SEQ + n * 128; const float lg = head_lg2(h);
        const bf16* vtp = VT + ((size_t)((b * 8 + h) * 64 + r)) * SEQ + n * 128 + 4 * hh;
        const bf16* pvp = PV + ((size_t)unit << 12) + r * 64 + 8 * hh;
#pragma unroll 1
        for (int ci = 0; ci < 4; ++ci) {
            const int c = 32 * ci + r;
            bf16x8_t qf[4];
#pragma unroll
            for (int s = 0; s < 4; ++s) qf[s] = *(const bf16x8_t*)(BR + (size_t)(r0 + c) * 2048 + h * 64 + 16 * s + 8 * hh);
            f32x16 o[2];
#pragma unroll
            for (int vt = 0; vt < 2; ++vt) {
#pragma unroll
                for (int i = 0; i < 16; ++i) o[vt][i] = 0.f;
#pragma unroll
                for (int s = 0; s < 4; ++s) { const bf16x8_t pa = *(const bf16x8_t*)(pvp + 32 * vt * 64 + 16 * s); o[vt] = __builtin_amdgcn_mfma_f32_32x32x16_bf16(pa, qf[s], o[vt], 0, 0, 0); }
            }
            { const float xi = exp2f(lg * (float)(c + 1));
#pragma unroll
              for (int vt = 0; vt < 2; ++vt)
#pragma unroll
                  for (int i = 0; i < 16; ++i) o[vt][i] *= xi; }
#pragma unroll 1
            for (int mi = 0; mi <= ci; ++mi) {
                f32x16 st;
#pragma unroll
                for (int i = 0; i < 16; ++i) st[i] = 0.f;
#pragma unroll
                for (int s = 0; s < 4; ++s) { const bf16x8_t ka = *(const bf16x8_t*)(BR + (size_t)(r0 + 32 * mi + r) * 2048 + 512 + h * 64 + 16 * s + 8 * hh);
                    st = __builtin_amdgcn_mfma_f32_32x32x16_bf16(ka, qf[s], st, 0, 0, 0); }
#pragma unroll
                for (int i = 0; i < 16; ++i) { const int m = 32 * mi + (i & 3) + 8 * (i >> 2) + 4 * hh; const int dm = c - m; st[i] = (dm >= 0) ? st[i] * exp2f(lg * (float)dm) : 0.f; }
#pragma unroll
                for (int s2 = 0; s2 < 2; ++s2) {
                    u32x4 pw; pw.x = pk2(st[8 * s2 + 0], st[8 * s2 + 1]); pw.y = pk2(st[8 * s2 + 2], st[8 * s2 + 3]); pw.z = pk2(st[8 * s2 + 4], st[8 * s2 + 5]); pw.w = pk2(st[8 * s2 + 6], st[8 * s2 + 7]);
                    const bf16x8_t pb = __builtin_bit_cast(bf16x8_t, pw);
#pragma unroll
                    for (int vt = 0; vt < 2; ++vt) { const bf16* vp = vtp + (size_t)32 * vt * SEQ + 32 * mi + 16 * s2;
                        const u32x2 lo = *(const u32x2*)vp, hi2 = *(const u32x2*)(vp + 8);
                        const bf16x8_t va = __builtin_bit_cast(bf16x8_t, (u32x4){lo.x, lo.y, hi2.x, hi2.y});
                        o[vt] = __builtin_amdgcn_mfma_f32_32x32x16_bf16(va, pb, o[vt], 0, 0, 0); }
                }
            }
            float ss = 0.f;
#pragma unroll
            for (int vt = 0; vt < 2; ++vt)
#pragma unroll
                for (int i = 0; i < 16; ++i) ss += o[vt][i] * o[vt][i];
            ss += __shfl_xor(ss, 32);
            const float rstd = 1.0f / sqrtf(ss * (1.f / 64.f) + EPS);
            const bf16* gp = BR + (size_t)(r0 + c) * 2048 + 1536 + h * 64 + 4 * hh; bf16* op = CAT + (size_t)(r0 + c) * 1024 + h * 64 + 4 * hh;
#pragma unroll
            for (int vt = 0; vt < 2; ++vt)
#pragma unroll
                for (int g4 = 0; g4 < 4; ++g4) { const u32x2 gw2 = *(const u32x2*)(gp + 32 * vt + 8 * g4);
                    const float g0 = bflo(gw2.x), g1 = bfhi(gw2.x), g2 = bflo(gw2.y), g3 = bfhi(gw2.y);
                    u32x2 ow; ow.x = pk2(o[vt][4 * g4] * rstd * silu_f(g0), o[vt][4 * g4 + 1] * rstd * silu_f(g1)); ow.y = pk2(o[vt][4 * g4 + 2] * rstd * silu_f(g2), o[vt][4 * g4 + 3] * rstd * silu_f(g3));
                    *(u32x2*)(op + 32 * vt + 8 * g4) = ow; }
        }
    }
}
__device__ __forceinline__ size_t sc_off(int b, int qb) { return (size_t)b * SC_BATCH + (size_t)16384 * (size_t)(qb * (qb + 1) / 2); }
__device__ __forceinline__ void phase_idx_scores(Frame& F) {
    const bf16* BI = (const bf16*)(F.ws + WS_BI); const float* IW = (const float*)(F.ws + WS_IW); float* SC = (float*)(F.ws + WS_SC);
    const int gw = F.bid * NWAVES + F.wave, NGW = F.G * NWAVES, lane = F.lane;
    for (int task = gw; task < 8 * 1056; task += NGW) {
        const int b = task & 7; int r = task >> 3; int qb = 0; while (r >= 2 * (qb + 1)) { r -= 2 * (qb + 1); ++qb; } const int kc = r;
        const int s = kc * 64 + lane; const int pitch = (qb + 1) * 128;
        unsigned kr[32];
        { const u32x4* kp = (const u32x4*)(BI + (size_t)(b * SEQ + s) * 576 + 512);
#pragma unroll
          for (int i = 0; i < 8; ++i) { const u32x4 w = kp[i]; kr[4 * i] = w.x; kr[4 * i + 1] = w.y; kr[4 * i + 2] = w.z; kr[4 * i + 3] = w.w; } }
        float* scb = SC + sc_off(b, qb) + s;
        for (int tq = 0; tq < 128; ++tq) { const int tok = b * SEQ + qb * 128 + tq; float sc = 0.f;
            const f32x4 w0 = *(const f32x4*)(IW + (size_t)tok * 8), w1 = *(const f32x4*)(IW + (size_t)tok * 8 + 4);
#pragma unroll
            for (int h = 0; h < 8; ++h) { const u32x4* qp = (const u32x4*)(BI + (size_t)tok * 576 + h * 64); float d = 0.f;
#pragma unroll
                for (int i = 0; i < 8; ++i) { const u32x4 w = qp[i];
#pragma unroll
                    for (int j = 0; j < 4; ++j) { d += bflo(w[j]) * bflo(kr[4 * i + j]); d += bfhi(w[j]) * bfhi(kr[4 * i + j]); } }
                const float wh = h < 4 ? w0[h & 3] : w1[h & 3]; sc += wh * fmaxf(d, 0.f); }
            scb[(size_t)tq * pitch] = sc; }
    }
}
__device__ __forceinline__ void phase_idx_scores_mfma(Frame& F) {
    const bf16* BI = (const bf16*)(F.ws + WS_BI); const float* IW = (const float*)(F.ws + WS_IW); float* SC = (float*)(F.ws + WS_SC);
    const int lane = F.lane, r = lane & 31, hh = lane >> 5, qs = F.wave & 1, kq = F.wave >> 1;
    for (int pairi = F.bid; pairi < 256; pairi += F.G) {
        const int b = pairi & 7, p = pairi >> 3;
#pragma unroll 1
        for (int hf = 0; hf < 2; ++hf) {
            const int qt = hf ? 63 - p : p; const int tok0 = b * SEQ + qt * 64;
            __syncthreads();
            { const int row = F.tid >> 3, ch = F.tid & 7; const u32x4* src = (const u32x4*)(BI + (size_t)(tok0 + row) * 576 + ch * 64); LAS u32x4* dst = (LAS u32x4*)(F.lds + row * 1040 + ch * 128);
#pragma unroll
              for (int i = 0; i < 8; ++i) dst[i] = src[i];
              if (F.tid < 128) *(LAS f32x4*)(F.lds + 66560 + F.tid * 16) = *(const f32x4*)(IW + (size_t)tok0 * 8 + F.tid * 4); }
            __syncthreads();
            const LAS float* wl = (const LAS float*)(F.lds + 66560) + (32 * qs + r) * 8;
            const int pitch = ((qt >> 1) + 1) * 128;
            float* scrow = SC + sc_off(b, qt >> 1) + (size_t)((qt & 1) * 64 + 32 * qs + r) * pitch;
            const LAS unsigned char* qbase = F.lds + (32 * qs + r) * 1040 + hh * 16;
            const bf16* kbase = BI + (size_t)(b * SEQ + r) * 576 + 512 + 8 * hh;
            bf16x8_t kf[2][4], kn[2][4];
#define IDX_LOADK(dst, k0) do { _Pragma("unroll") for (int tl = 0; tl < 2; ++tl) _Pragma("unroll") for (int s = 0; s < 4; ++s) dst[tl][s] = *(const bf16x8_t*)(kbase + (size_t)((k0) + 32 * tl) * 576 + 16 * s); } while (0)
            int k0 = 64 * kq; const int klim = 64 * qt;
            if (k0 <= klim) IDX_LOADK(kf, k0);
#pragma unroll 1
            for (; k0 <= klim; k0 += 256) {
                const bool more = (k0 + 256) <= klim;
                if (more) IDX_LOADK(kn, k0 + 256);
                f32x16 sc0, sc1;
#pragma unroll
                for (int i = 0; i < 16; ++i) { sc0[i] = 0.f; sc1[i] = 0.f; }
#pragma unroll 1
                for (int h = 0; h < 8; ++h) {
                    const float wh = wl[h];
                    bf16x8_t qf[4];
#pragma unroll
                    for (int s = 0; s < 4; ++s) qf[s] = *(const LAS bf16x8_t*)(qbase + h * 128 + s * 32);
                    f32x16 a0, a1;
#pragma unroll
                    for (int i = 0; i < 16; ++i) { a0[i] = 0.f; a1[i] = 0.f; }
#pragma unroll
                    for (int s = 0; s < 4; ++s) { a0 = __builtin_amdgcn_mfma_f32_32x32x16_bf16(kf[0][s], qf[s], a0, 0, 0, 0); a1 = __builtin_amdgcn_mfma_f32_32x32x16_bf16(kf[1][s], qf[s], a1, 0, 0, 0); }
#pragma unroll
                    for (int i = 0; i < 16; ++i) { sc0[i] = fmaf(wh, fmaxf(a0[i], 0.f), sc0[i]); sc1[i] = fmaf(wh, fmaxf(a1[i], 0.f), sc1[i]); }
                }
#pragma unroll
                for (int g = 0; g < 4; ++g) {
                    *(f32x4*)(scrow + k0 + 8 * g + 4 * hh) = (f32x4){sc0[4 * g], sc0[4 * g + 1], sc0[4 * g + 2], sc0[4 * g + 3]};
                    *(f32x4*)(scrow + k0 + 32 + 8 * g + 4 * hh) = (f32x4){sc1[4 * g], sc1[4 * g + 1], sc1[4 * g + 2], sc1[4 * g + 3]}; }
                if (more) {
#pragma unroll
                    for (int tl = 0; tl < 2; ++tl)
#pragma unroll
                        for (int s = 0; s < 4; ++s) kf[tl][s] = kn[tl][s]; }
            }
#undef IDX_LOADK
        }
    }
    __syncthreads();
}
__device__ __forceinline__ void phase_select(Frame& F) {
    const float* SC = (const float*)(F.ws + WS_SC); bf16* SEL = (bf16*)(F.ws + WS_SEL);
    const int gw = F.bid * NWAVES + F.wave, NGW = F.G * NWAVES, lane = F.lane;
    const unsigned long long lt = (1ull << lane) - 1ull;
    for (int tok = gw; tok < M; tok += NGW) {
        const int t = tok & (SEQ - 1), b = tok >> 12; if (t < 256) continue;
        const int L = t + 1, qb = t >> 7, pitch = (qb + 1) * 128;
        const float* rowp = SC + sc_off(b, qb) + (size_t)(t & 127) * pitch;
        unsigned u[64];
#pragma unroll
        for (int j = 0; j < 64; ++j) { u[j] = 0u; if (64 * j < L) { const int s = 64 * j + lane; const float f = rowp[s]; unsigned bits = __float_as_uint(f); if (f == 0.f) bits = 0u;
            const unsigned key = (bits & 0x80000000u) ? ~bits : (bits | 0x80000000u); u[j] = (s < L) ? key : 0u; } }
        unsigned T = 0u;
        for (int bit = 31; bit >= 0; --bit) { const unsigned cand = T | (1u << bit); int cnt = 0;
#pragma unroll
            for (int j = 0; j < 64; ++j) cnt += (u[j] >= cand) ? 1 : 0;
            cnt = wave_sum_i(cnt); if (cnt >= 256) T = cand; }
        int ngt = 0;
#pragma unroll
        for (int j = 0; j < 64; ++j) ngt += (u[j] > T) ? 1 : 0;
        ngt = wave_sum_i(ngt); const int need_eq = 256 - ngt;
        int pos = 0, eqc = 0; bf16* out = SEL + (size_t)tok * 256;
#pragma unroll
        for (int j = 0; j < 64; ++j) { if (64 * j < L) {
            const bool gt = u[j] > T, eq = u[j] == T; const unsigned long long meq = __ballot(eq);
            const bool take = gt || (eq && (eqc + __popcll(meq & lt)) < need_eq); const unsigned long long mt = __ballot(take);
            if (take) out[pos + __popcll(mt & lt)] = (bf16)(64 * j + lane);
            pos += __popcll(mt); eqc += __popcll(meq); } }
    }
}
__device__ __forceinline__ void phase_attn(Frame& F) {
    const bf16* BA = (const bf16*)(F.ws + WS_BA); const bf16* SEL = (const bf16*)(F.ws + WS_SEL); bf16* CAT = (bf16*)(F.ws + WS_CAT);
    const int gw = F.bid * NWAVES + F.wave, NGW = F.G * NWAVES, lane = F.lane;
    LAS float* pl = (LAS float*)(F.lds + F.wave * 16384);
    LAS int* il = (LAS int*)(F.lds + F.wave * 16384 + 8192);
    for (int tok = gw; tok < M; tok += NGW) {
        const int t = tok & (SEQ - 1), b = tok >> 12; const int nk = t + 1 < 256 ? t + 1 : 256;
        float lg[8][4]; int idx[4];
#pragma unroll
        for (int i = 0; i < 4; ++i) { const int j = lane + 64 * i; idx[i] = (t < 256) ? (j < nk ? j : 0) : (int)SEL[(size_t)tok * 256 + j];
            unsigned kr[32]; { const u32x4* kp = (const u32x4*)(BA + (size_t)(b * SEQ + idx[i]) * 640 + 512);
#pragma unroll
                for (int c = 0; c < 8; ++c) { const u32x4 w = kp[c]; kr[4 * c] = w.x; kr[4 * c + 1] = w.y; kr[4 * c + 2] = w.z; kr[4 * c + 3] = w.w; } }
#pragma unroll
            for (int h = 0; h < 8; ++h) { const u32x4* qp = (const u32x4*)(BA + (size_t)tok * 640 + h * 64); float d = 0.f;
#pragma unroll
                for (int c = 0; c < 8; ++c) { const u32x4 w = qp[c];
#pragma unroll
                    for (int e = 0; e < 4; ++e) { d += bflo(w[e]) * bflo(kr[4 * c + e]); d += bfhi(w[e]) * bfhi(kr[4 * c + e]); } }
                lg[h][i] = (j < nk) ? d : -1e30f; } }
#pragma unroll
        for (int h = 0; h < 8; ++h) { float mx = fmaxf(fmaxf(lg[h][0], lg[h][1]), fmaxf(lg[h][2], lg[h][3])); mx = wave_max(mx); float e[4], sm = 0.f;
#pragma unroll
            for (int i = 0; i < 4; ++i) { e[i] = (lane + 64 * i < nk) ? __expf(lg[h][i] - mx) : 0.f; sm += e[i]; }
            sm = wave_sum(sm); const float inv = 1.0f / sm;
#pragma unroll
            for (int i = 0; i < 4; ++i) pl[(lane + 64 * i) * 8 + h] = e[i] * inv; }
#pragma unroll
        for (int i = 0; i < 4; ++i) il[lane + 64 * i] = idx[i];
        asm volatile("s_waitcnt lgkmcnt(0)" ::: "memory");
        float o[8];
#pragma unroll
        for (int h = 0; h < 8; ++h) o[h] = 0.f;
        for (int j = 0; j < nk; ++j) { const int kidx = il[j]; const float v = bf2f(BA[(size_t)(b * SEQ + kidx) * 640 + 576 + lane]);
            const f32x4 p0 = *(const LAS f32x4*)(pl + j * 8), p1 = *(const LAS f32x4*)(pl + j * 8 + 4);
            o[0] += p0.x * v; o[1] += p0.y * v; o[2] += p0.z * v; o[3] += p0.w * v; o[4] += p1.x * v; o[5] += p1.y * v; o[6] += p1.z * v; o[7] += p1.w * v; }
#pragma unroll
        for (int h = 0; h < 8; ++h) CAT[(size_t)tok * 1024 + 512 + h * 64 + lane] = (bf16)f2bf(o[h]);
        asm volatile("s_waitcnt lgkmcnt(0)" ::: "memory");
    }
}

__device__ __forceinline__ void phase_attn_mfma(Frame& F) {
    const bf16* BA = (const bf16*)(F.ws + WS_BA); const bf16* SEL = (const bf16*)(F.ws + WS_SEL); bf16* CAT = (bf16*)(F.ws + WS_CAT);
    const int lane = F.lane, li = lane & 15, g = lane >> 4;
    LAS unsigned char* vl = F.lds + F.wave * 16384;
    const int b = F.bid & 7, wslot = (F.bid >> 3) * NWAVES + F.wave, nslot = (F.G >> 3) * NWAVES;
    for (int t = wslot; t < SEQ; t += nslot) {
        const int tok = b * SEQ + t; const int nk = t + 1 < 256 ? t + 1 : 256; const bool full = t >= 256;
        const bf16* selp = SEL + (size_t)tok * 256;
        bf16x8_t qb[2];
#pragma unroll
        for (int ks = 0; ks < 2; ++ks) { qb[ks] = (bf16x8_t){0, 0, 0, 0, 0, 0, 0, 0}; if (li < 8) qb[ks] = *(const bf16x8_t*)(BA + (size_t)tok * 640 + li * 64 + 32 * ks + 8 * g); }
        f32x4 lg[16];
#pragma unroll
        for (int T = 0; T < 16; ++T) {
            const int slot = 16 * T + li; const int kidx = full ? (int)selp[slot] : (slot < nk ? slot : 0);
            const bf16* kp = BA + (size_t)(b * SEQ + kidx) * 640 + 512 + 8 * g;
            const bf16x8_t a0 = *(const bf16x8_t*)kp, a1 = *(const bf16x8_t*)(kp + 32);
            f32x4 c = (f32x4){0.f, 0.f, 0.f, 0.f};
            c = __builtin_amdgcn_mfma_f32_16x16x32_bf16(a0, qb[0], c, 0, 0, 0);
            c = __builtin_amdgcn_mfma_f32_16x16x32_bf16(a1, qb[1], c, 0, 0, 0);
            lg[T] = c;
        }
        float mx = -3.0e38f;
#pragma unroll
        for (int T = 0; T < 16; ++T)
#pragma unroll
            for (int i = 0; i < 4; ++i) { if (!full && (16 * T + 4 * g + i) >= nk) lg[T][i] = -3.0e38f; mx = fmaxf(mx, lg[T][i]); }
        mx = fmaxf(mx, __shfl_xor(mx, 16)); mx = fmaxf(mx, __shfl_xor(mx, 32));
        float sm = 0.f;
#pragma unroll
        for (int T = 0; T < 16; ++T)
#pragma unroll
            for (int i = 0; i < 4; ++i) { const float e = __expf(lg[T][i] - mx); lg[T][i] = e; sm += e; }
        sm += __shfl_xor(sm, 16); sm += __shfl_xor(sm, 32);
        f32x4 o[4];
#pragma unroll
        for (int nt = 0; nt < 4; ++nt) o[nt] = (f32x4){0.f, 0.f, 0.f, 0.f};
#pragma unroll
        for (int ps = 0; ps < 4; ++ps) {
#pragma unroll
            for (int i = 0; i < 8; ++i) { const int row = 8 * i + (lane >> 3), slot = 64 * ps + row; const int kidx = full ? (int)selp[slot] : (slot < nk ? slot : 0);
                const u32x4 v = *(const u32x4*)(BA + (size_t)(b * SEQ + kidx) * 640 + 576 + 8 * (lane & 7));
                *(LAS u32x4*)(vl + row * 160 + (lane & 7) * 16) = v; }
#pragma unroll
            for (int k2 = 0; k2 < 2; ++k2) { const int ks2 = 2 * ps + k2;
                const f32x4 p0 = lg[2 * ks2], p1 = lg[2 * ks2 + 1];
                unsigned pw[4]; pw[0] = pk2(p0[0], p0[1]); pw[1] = pk2(p0[2], p0[3]); pw[2] = pk2(p1[0], p1[1]); pw[3] = pk2(p1[2], p1[3]);
                const bf16x8_t pa = __builtin_bit_cast(bf16x8_t, (u32x4){pw[0], pw[1], pw[2], pw[3]});
                const int R0 = 32 * k2 + 4 * g + (li >> 2);
#pragma unroll
                for (int nt = 0; nt < 4; ++nt) {
                    const LAS unsigned char* ap = vl + R0 * 160 + (16 * nt + 4 * (li & 3)) * 2;
                    const v4i16_t lo = __builtin_amdgcn_ds_read_tr16_b64_v4i16((LAS v4i16_t*)ap);
                    const v4i16_t hi = __builtin_amdgcn_ds_read_tr16_b64_v4i16((LAS v4i16_t*)(ap + 16 * 160));
                    const bf16x8_t vb = (bf16x8_t){lo[0], lo[1], lo[2], lo[3], hi[0], hi[1], hi[2], hi[3]};
                    o[nt] = __builtin_amdgcn_mfma_f32_16x16x32_bf16(pa, vb, o[nt], 0, 0, 0);
                }
            }
        }
#pragma unroll
        for (int i = 0; i < 4; ++i) { const float s_h = __shfl(sm, (4 * g + i) & 15); const float inv = 1.0f / s_h;
            if (g < 2) {
#pragma unroll
                for (int nt = 0; nt < 4; ++nt) CAT[(size_t)tok * 1024 + 512 + (4 * g + i) * 64 + 16 * nt + li] = (bf16)f2bf(o[nt][i] * inv); } }
    }
}
__device__ __forceinline__ void phase_norm1(Frame& F) {
    const bf16* MIX = (const bf16*)(F.ws + WS_MIX); bf16* HN2 = (bf16*)(F.ws + WS_HN2);
    const int gw = F.bid * NWAVES + F.wave, NGW = F.G * NWAVES, lane = F.lane;
    for (int m = gw; m < M; m += NGW) {
        const u32x2* mr = (const u32x2*)(MIX + (size_t)m * DM) + lane; const f32x4* xr = (const f32x4*)(F.x + (size_t)m * DM) + lane;
        const f32x4* g1 = (const f32x4*)F.g_mix_post + lane; const f32x4* g2 = (const f32x4*)F.g_ffn_pre + lane;
        f32x4 v[4]; float s = 0.f;
#pragma unroll
        for (int j = 0; j < 4; ++j) { const u32x2 w = mr[64 * j]; v[j] = (f32x4){bflo(w.x), bfhi(w.x), bflo(w.y), bfhi(w.y)}; s += (v[j].x * v[j].x + v[j].y * v[j].y) + (v[j].z * v[j].z + v[j].w * v[j].w); }
        const float rstd = 1.0f / sqrtf(wave_sum(s) * (1.f / DM) + EPS); float s2 = 0.f;
        f32x4* orow = (f32x4*)(F.out + (size_t)m * DM) + lane;
#pragma unroll
        for (int j = 0; j < 4; ++j) { v[j] = xr[64 * j] + v[j] * rstd * g1[64 * j]; orow[64 * j] = v[j]; s2 += (v[j].x * v[j].x + v[j].y * v[j].y) + (v[j].z * v[j].z + v[j].w * v[j].w); }
        const float rstd2 = 1.0f / sqrtf(wave_sum(s2) * (1.f / DM) + EPS);
        unsigned long long* o8 = (unsigned long long*)(HN2 + (size_t)m * DM) + lane;
#pragma unroll
        for (int j = 0; j < 4; ++j) { const f32x4 gg = g2[64 * j];
            o8[64 * j] = (unsigned long long)pk2(v[j].x * rstd2 * gg.x, v[j].y * rstd2 * gg.y) | ((unsigned long long)pk2(v[j].z * rstd2 * gg.z, v[j].w * rstd2 * gg.w) << 32); }
    }
}
__device__ __forceinline__ void phase_norm2(Frame& F) {
    const bf16* FFN = (const bf16*)(F.ws + WS_FFN);
    const int gw = F.bid * NWAVES + F.wave, NGW = F.G * NWAVES, lane = F.lane;
    for (int m = gw; m < M; m += NGW) {
        const u32x2* mr = (const u32x2*)(FFN + (size_t)m * DM) + lane; const f32x4* g1 = (const f32x4*)F.g_ffn_post + lane;
        f32x4 v[4]; float s = 0.f;
#pragma unroll
        for (int j = 0; j < 4; ++j) { const u32x2 w = mr[64 * j]; v[j] = (f32x4){bflo(w.x), bfhi(w.x), bflo(w.y), bfhi(w.y)}; s += (v[j].x * v[j].x + v[j].y * v[j].y) + (v[j].z * v[j].z + v[j].w * v[j].w); }
        const float rstd = 1.0f / sqrtf(wave_sum(s) * (1.f / DM) + EPS);
        f32x4* orow = (f32x4*)(F.out + (size_t)m * DM) + lane;
#pragma unroll
        for (int j = 0; j < 4; ++j) orow[64 * j] = orow[64 * j] + v[j] * rstd * g1[64 * j];
    }
}

__device__ __forceinline__ float dpp_shr1(float old, float src) { return __int_as_float(__builtin_amdgcn_update_dpp(__float_as_int(old), __float_as_int(src), 0x111, 0xf, 0xf, false)); }
__device__ __forceinline__ float dpp_shr2(float old, float src) { return __int_as_float(__builtin_amdgcn_update_dpp(__float_as_int(old), __float_as_int(src), 0x112, 0xf, 0xf, false)); }
__device__ __forceinline__ float dpp_ror1(float src) { return __int_as_float(__builtin_amdgcn_update_dpp(0, __float_as_int(src), 0x121, 0xf, 0xf, false)); }
__device__ __forceinline__ float dpp_ror2(float src) { return __int_as_float(__builtin_amdgcn_update_dpp(0, __float_as_int(src), 0x122, 0xf, 0xf, false)); }
struct EpiUp {
    static constexpr bool PERM = true, AFTER_DRAIN = false;
    unsigned char* ws; const float* conv_w; const float* conv_b;
    __device__ __forceinline__ void operator()(const pg8::f32x4 (&acc)[2][2][4][2], const pg8::Unit& u, int wr, int wc, int fr, int fq, PG8_LAS unsigned char* xl) const {
        PG8_LAS float* X = (PG8_LAS float*)xl;
        const int cl = 32 * wc + 8 * fq;
        if (fr >= 14) {
#pragma unroll
            for (int ai = 0; ai < 2; ++ai)
#pragma unroll
                for (int bj = 0; bj < 2; ++bj)
#pragma unroll
                    for (int n = 0; n < 2; ++n) *(PG8_LAS f32x4*)(X + ((ai * 2 + wr) * 2 + (fr - 14)) * 256 + bj * 128 + cl + 4 * n) = acc[ai][bj][3][n];
            if (wr == 1) { float* H = (float*)(ws + WS_HALO) + ((size_t)(u.pm * 22 + u.pn) * 2 + (fr - 14)) * 256;
#pragma unroll
                for (int bj = 0; bj < 2; ++bj)
#pragma unroll
                    for (int n = 0; n < 2; ++n) *(f32x4*)(H + bj * 128 + cl + 4 * n) = acc[1][bj][3][n]; }
        }
        asm volatile("s_waitcnt lgkmcnt(0)" ::: "memory"); __builtin_amdgcn_s_barrier(); asm volatile("" ::: "memory");
        const bool seq_start = (u.pm & 15) == 0;
        bf16* ACT = (bf16*)(ws + WS_ACT);
#pragma unroll
        for (int n = 0; n < 2; ++n) {
            f32x4 w0[2], w1[2], w2[2], bb[2];
#pragma unroll
            for (int bj = 0; bj < 2; ++bj) { const int ch = bj * DFF + 128 * u.pn + cl + 4 * n;
                w0[bj] = *(const f32x4*)(conv_w + ch); w1[bj] = *(const f32x4*)(conv_w + NUP + ch); w2[bj] = *(const f32x4*)(conv_w + 2 * NUP + ch); bb[bj] = *(const f32x4*)(conv_b + ch); }
#pragma unroll
            for (int ai = 0; ai < 2; ++ai) {
                const bool has_pred = !(ai == 0 && wr == 0);
                const int pai = (wr == 1) ? ai : 0, pwr = (wr == 1) ? 0 : 1;
#pragma unroll
                for (int m = 0; m < 4; ++m) {
                    f32x4 y[2];
#pragma unroll
                    for (int bj = 0; bj < 2; ++bj) {
                        const f32x4 cur = acc[ai][bj][m][n]; f32x4 p1, p2;
                        if (m == 0) {
                            f32x4 x0 = (f32x4){0.f, 0.f, 0.f, 0.f}, x1 = x0;
                            if (has_pred) { const PG8_LAS float* xp = X + ((pai * 2 + pwr) * 2) * 256 + bj * 128 + cl + 4 * n; x0 = *(const PG8_LAS f32x4*)xp; x1 = *(const PG8_LAS f32x4*)(xp + 256); }
                            const f32x4 o2 = (fr == 0) ? x0 : x1;
#pragma unroll
                            for (int e = 0; e < 4; ++e) { p1[e] = dpp_shr1(x1[e], cur[e]); p2[e] = dpp_shr2(o2[e], cur[e]); }
                        } else {
                            const f32x4 prv = acc[ai][bj][m > 0 ? m - 1 : 0][n];
#pragma unroll
                            for (int e = 0; e < 4; ++e) { p1[e] = dpp_shr1(dpp_ror1(prv[e]), cur[e]); p2[e] = dpp_shr2(dpp_ror2(prv[e]), cur[e]); }
                        }
                        y[bj] = bb[bj] + w2[bj] * cur + w1[bj] * p1 + w0[bj] * p2;
                    }
                    const int row = u.pm * 256 + ai * 128 + wr * 64 + m * 16 + fr;
                    const bool partial = (ai == 0 && wr == 0 && m == 0 && fr < 2 && !seq_start);
                    if (partial) { float* P = (float*)(ws + WS_PART) + ((size_t)(u.pm * 22 + u.pn) * 2 + fr) * 256 + cl + 4 * n; *(f32x4*)P = y[0]; *(f32x4*)(P + 128) = y[1]; }
                    else { f32x4 a;
#pragma unroll
                        for (int e = 0; e < 4; ++e) a[e] = silu_f(y[0][e]) * y[1][e];
                        u32x2 pk; pk.x = pk2(a[0], a[1]); pk.y = pk2(a[2], a[3]);
                        *(u32x2*)(ACT + (size_t)row * DFF + 128 * u.pn + cl + 4 * n) = pk; }
                    asm volatile("" ::: "memory");
                }
            }
        }
    }
};
__device__ __forceinline__ void phase_fixup(Frame& F) {
    const float* H = (const float*)(F.ws + WS_HALO); const float* P = (const float*)(F.ws + WS_PART); bf16* ACT = (bf16*)(F.ws + WS_ACT);
    const int total = 128 * 22 * 2 * 128;
    for (int i = F.bid * NTHREADS + F.tid; i < total; i += F.G * NTHREADS) {
        const int c = i & 127, j = (i >> 7) & 1, pn = (i >> 8) % 22, pm = (i >> 8) / 22;
        if ((pm & 15) == 0) continue;
        const float* pp = P + ((size_t)(pm * 22 + pn) * 2 + j) * 256; const float* hp = H + ((size_t)((pm - 1) * 22 + pn) * 2) * 256;
        float y[2];
#pragma unroll
        for (int bj = 0; bj < 2; ++bj) { const int ch = bj * DFF + 128 * pn + c; const float w0 = F.conv_w[ch], w1 = F.conv_w[NUP + ch];
            const float h0 = hp[bj * 128 + c], h1 = hp[256 + bj * 128 + c];
            y[bj] = pp[bj * 128 + c] + (j == 0 ? (w1 * h1 + w0 * h0) : (w0 * h1)); }
        ACT[(size_t)(pm * 256 + j) * DFF + 128 * pn + c] = (bf16)f2bf(silu_f(y[0]) * y[1]);
    }
}

__global__ void __launch_bounds__(NTHREADS, 2) hymba_fwd(Args args) {
    extern __shared__ __attribute__((aligned(16))) unsigned char lds_raw[];
    Frame F;
    F.lds = (LAS unsigned char*)lds_raw;
    F.tid = threadIdx.x; F.lane = F.tid & 63; F.wave = __builtin_amdgcn_readfirstlane(F.tid >> 6); F.G = gridDim.x; F.bid = blockIdx.x;
    F.x = args.in[0]; F.g_mix_pre = args.in[1]; F.g_mix_post = args.in[2]; F.w_in = args.in[3]; F.w_out = args.in[4]; F.g_ffn_pre = args.in[5]; F.g_ffn_post = args.in[6];
    F.w_up = args.in[7]; F.conv_w = args.in[8]; F.conv_b = args.in[9]; F.w_down = args.in[10]; F.out = args.out; F.ws = args.ws;
    const int lo = args.ph_lo, hi = args.ph_hi;
    cg::grid_group grid = cg::this_grid();
#define IN(k) (lo <= (k) && (k) < hi)
#define SEAM(k) do { if (IN(k) && IN((k) + 1)) { if (args.coop) grid.sync(); } } while (0)
    if (IN(0)) { phase_prologue(F); } SEAM(0);
    if (IN(1)) { pg8::Gemm g{(const bf16*)(F.ws + WS_HN), (const bf16*)(F.ws + WS_WIN), M, NPROJ, DM}; pg8::StaticOrder S; S.init(M, NPROJ, F.G, F.bid);
        EpiProj E{F.ws}; pg8::gemm_phase<EpiProj, pg8::StaticOrder, true, true>(F.lds, g, S, E); } SEAM(1);
    if (IN(2)) { phase_ret_state_mfma(F); } SEAM(2);
    if (IN(3)) { phase_ret_scan(F); } SEAM(3);
    if (IN(4)) { phase_ret_out_mfma(F); } SEAM(4);
    if (IN(5)) { phase_idx_scores_mfma(F); } SEAM(5);
    if (IN(6)) { phase_select(F); } SEAM(6);
    if (IN(7)) { phase_attn_mfma(F); } SEAM(7);
    if (IN(8)) { pg8::Gemm g{(const bf16*)(F.ws + WS_CAT), (const bf16*)(F.ws + WS_WOUT), M, DM, DM}; pg8::StaticOrder S; S.init(M, DM, F.G, F.bid);
        pg8::EpiStore E{(bf16*)(F.ws + WS_MIX), DM}; pg8::gemm_phase<pg8::EpiStore, pg8::StaticOrder, true, true>(F.lds, g, S, E); } SEAM(8);
    if (IN(9)) { phase_norm1(F); } SEAM(9);
    if (IN(10)) { pg8::Gemm g{(const bf16*)(F.ws + WS_HN2), (const bf16*)(F.ws + WS_WUP), M, NUP, DM}; pg8::StaticOrder S; S.init(M, NUP, F.G, F.bid);
        EpiUp E{F.ws, F.conv_w, F.conv_b}; pg8::gemm_phase<EpiUp, pg8::StaticOrder, true, true>(F.lds, g, S, E); } SEAM(10);
    if (IN(11)) { phase_fixup(F); } SEAM(11);
    if (IN(12)) { pg8::Gemm g{(const bf16*)(F.ws + WS_ACT), (const bf16*)(F.ws + WS_WDN), M, DM, DFF}; pg8::StaticOrder S; S.init(M, DM, F.G, F.bid);
        pg8::EpiStore E{(bf16*)(F.ws + WS_FFN), DM}; pg8::gemm_phase<pg8::EpiStore, pg8::StaticOrder, true, true>(F.lds, g, S, E); } SEAM(12);
    if (IN(13)) { phase_norm2(F); }
#undef IN
#undef SEAM
}

extern "C" void kernel_launch(void* const* d_in, const int* in_sizes, int n_in, void* d_out, int out_size, void* d_ws, size_t ws_size, hipStream_t stream) {
    static int grid = 0;
    if (grid == 0) {
        if (n_in != 11 || in_sizes[0] != M * DM || out_size != M * DM || ws_size < WS_END) { fprintf(stderr, "kernel_launch: unexpected shapes (n_in %d, in0 %d, out %d, ws %zu)\n", n_in, n_in > 0 ? in_sizes[0] : -1, out_size, ws_size); grid = -1; return; }
        int dev = 0, cus = 0, per_cu = 0;
        hipGetDevice(&dev); hipDeviceGetAttribute(&cus, hipDeviceAttributeMultiprocessorCount, dev);
        hipFuncSetAttribute((const void*)hymba_fwd, hipFuncAttributeMaxDynamicSharedMemorySize, LDS_BYTES);
        hipOccupancyMaxActiveBlocksPerMultiprocessor(&per_cu, (const void*)hymba_fwd, NTHREADS, LDS_BYTES);
        if (per_cu < 1) { fprintf(stderr, "kernel_launch: occupancy query says %d blocks per CU\n", per_cu); per_cu = 1; }
        (void)hipGetLastError();
        grid = cus * 1;
    }
    if (grid < 0) return;
    Args a{};
    for (int i = 0; i < 11; ++i) a.in[i] = (const float*)d_in[i];
    a.out = (float*)d_out; a.ws = (unsigned char*)d_ws;
#if MK_MULTI
    for (int p = 0; p < NPHASE; ++p) { a.ph_lo = p; a.ph_hi = p + 1; a.coop = 0; hipLaunchKernelGGL(hymba_fwd, dim3(grid), dim3(NTHREADS), LDS_BYTES, stream, a); }
#else
    a.ph_lo = 0; a.ph_hi = NPHASE; a.coop = 1;
    void* kargs[] = {&a};
    hipError_t e = hipLaunchCooperativeKernel((const void*)hymba_fwd, dim3(grid), dim3(NTHREADS), kargs, LDS_BYTES, stream);
    if (e != hipSuccess) fprintf(stderr, "cooperative launch failed: %s (grid %d)\n", hipGetErrorString(e), grid);
#endif
}
```

```cpp
#include <hip/hip_runtime.h>
#include <hip/hip_cooperative_groups.h>
#include <cstdio>
#include <cstdint>
namespace cg = cooperative_groups;

#ifndef MK_MULTI
#define MK_MULTI 0
#endif

namespace pg8 {
#define PG8_LAS __attribute__((address_space(3)))
typedef unsigned short bf16_t;
typedef short bf16x8 __attribute__((ext_vector_type(8)));
typedef float f32x4 __attribute__((ext_vector_type(4)));
typedef unsigned u32x4 __attribute__((ext_vector_type(4)));
typedef unsigned u32x2 __attribute__((ext_vector_type(2)));
constexpr int BM = 256, BK = 64, HALF = 128, HTB = HALF * BK * 2, STAGE_BYTES = 8 * HTB, NXCD = 8, WGM = 8;

__host__ __device__ __forceinline__ int lds_byte(int r, int c) { const int st = (r >> 4) * 2 + (c >> 5), rr = r & 15, cc = c & 31, ob = rr * 64 + cc * 2; return st * 1024 + (ob ^ (((ob >> 9) & 1) << 5)); }
__host__ __device__ __forceinline__ void stage_rc(int b, int& R, int& C) { const int st = b / 1024, sb = b % 1024, swz = sb ^ (((sb >> 9) & 1) << 5); R = (st >> 1) * 16 + swz / 64; C = (st & 1) * 32 + (swz % 64) / 2; }
__host__ __device__ __forceinline__ int perm32(int rho) { const int n = rho >> 4, i = rho & 15; return 8 * (i >> 2) + 4 * n + (i & 3); }

struct Unit { int pm, pn; };
struct Gemm { const bf16_t* A; const bf16_t* Bt; int M, N, K; };

struct StaticOrder {
    int nM, nN, nwg, G, c;
    __host__ __device__ void init(int M, int N, int G_, int c_) { nM = M / BM; nN = N / BM; nwg = nM * nN; G = G_; c = c_; }
    __host__ __device__ bool next(int i, Unit& u) const {
        const long L = (long)i * G + c; if (L >= nwg) return false;
        int wgid = (int)L; { const int q = nwg / NXCD, r = nwg % NXCD, xcd = wgid % NXCD, off = wgid / NXCD; wgid = (xcd < r ? xcd * (q + 1) : r * (q + 1) + (xcd - r) * q) + off; }
        const int nig = WGM * nN, gid = wgid / nig, fm = gid * WGM, gsz = (nM - fm) < WGM ? (nM - fm) : WGM;
        u.pm = fm + ((wgid % nig) % gsz); u.pn = (wgid % nig) / gsz; return true;
    }
    __device__ __forceinline__ void a_ready(const Unit&) const {}
    __device__ __forceinline__ void done(const Unit&) const {}
};

__device__ __forceinline__ unsigned cvt_pk_bf16(float lo, float hi) { unsigned r; asm volatile("v_cvt_pk_bf16_f32 %0, %1, %2" : "=v"(r) : "v"(lo), "v"(hi)); return r; }

struct EpiStore {
    static constexpr bool PERM = true, AFTER_DRAIN = false, NEEDS_LDS = false;
    bf16_t* O; int ldc;
    __device__ __forceinline__ void operator()(const f32x4 (&acc)[2][2][4][2], const Unit& u, int wr, int wc, int fr, int fq, PG8_LAS unsigned char*) const {
        const int row0 = u.pm * BM + wr * 64 + fr; const int col0 = u.pn * BM + wc * 32 + 8 * fq;
#pragma unroll
        for (int ai = 0; ai < 2; ++ai)
#pragma unroll
            for (int m = 0; m < 4; ++m) { bf16_t* rowp = O + (size_t)(row0 + ai * HALF + m * 16) * ldc + col0;
#pragma unroll
                for (int bj = 0; bj < 2; ++bj) { const f32x4 v0 = acc[ai][bj][m][0], v1 = acc[ai][bj][m][1];
                    u32x4 w; w.x = cvt_pk_bf16(v0[0], v0[1]); w.y = cvt_pk_bf16(v0[2], v0[3]); w.z = cvt_pk_bf16(v1[0], v1[1]); w.w = cvt_pk_bf16(v1[2], v1[3]);
                    *(u32x4*)(rowp + bj * HALF) = w; } }
    }
};

template <class Epi, class Sched, bool ALIGN_EPI = false, bool SP2 = false>
__device__ __forceinline__ void gemm_phase(PG8_LAS unsigned char* lds, const Gemm g, const Sched& S, const Epi& E) {
    const int tid = threadIdx.x, wid = __builtin_amdgcn_readfirstlane(tid >> 6), lane = tid & 63, wr = wid >> 2, wc = wid & 3, fr = lane & 15, fq = lane >> 4;
    const int K = g.K, nt = K / BK;
    unsigned voffA[2], voffB[2];
#pragma unroll
    for (int i = 0; i < 2; ++i) { int R, C; stage_rc(tid * 16 + i * 8192, R, C); const int Rb = Epi::PERM ? ((R & ~31) + perm32(R & 31)) : R;
        voffA[i] = (unsigned)(R * K + C) * 2u; voffB[i] = (unsigned)(Rb * K + C) * 2u; }
    const size_t kstep = (size_t)(BK * 2);
    const size_t hstep = (size_t)HALF * K * 2;
    const size_t tstep = 2 * hstep;
    const unsigned ldsw = (unsigned)wid * 1024u;
    const int aoff = lds_byte(wr * 64 + fr, fq * 8), boff = lds_byte(wc * 32 + fr, fq * 8);
#define PG8_SA(b, h) (((b) * 2 + (h)) * HTB)
#define PG8_SB(b, h) ((4 + (b) * 2 + (h)) * HTB)
#define PG8_STAGE(bufoff, gbase, voff) do { _Pragma("unroll") for (int _i = 0; _i < 2; ++_i) \
        __builtin_amdgcn_global_load_lds((const unsigned*)((const char*)(gbase) + (voff)[_i]), (PG8_LAS unsigned*)(lds + (bufoff) + ldsw + _i * 8192), 16, 0, 0); } while (0)
#define PG8_LDA(dst, b, h) do { _Pragma("unroll") for (int m = 0; m < 4; ++m) _Pragma("unroll") for (int k = 0; k < 2; ++k) dst[m][k] = *(const PG8_LAS bf16x8*)(lds + PG8_SA(b, h) + aoff + m * 2048 + k * 1024); } while (0)
#define PG8_LDB(dst, b, h) do { _Pragma("unroll") for (int n = 0; n < 2; ++n) _Pragma("unroll") for (int k = 0; k < 2; ++k) dst[n][k] = *(const PG8_LAS bf16x8*)(lds + PG8_SB(b, h) + boff + n * 2048 + k * 1024); } while (0)
#define PG8_MMA(ai, bj, At, Bt) do { __builtin_amdgcn_s_setprio(1); _Pragma("unroll") for (int m = 0; m < 4; ++m) _Pragma("unroll") for (int n = 0; n < 2; ++n) _Pragma("unroll") for (int k = 0; k < 2; ++k) \
        acc[ai][bj][m][n] = __builtin_amdgcn_mfma_f32_16x16x32_bf16(Bt[n][k], At[m][k], acc[ai][bj][m][n], 0, 0, 0); __builtin_amdgcn_s_setprio(0); } while (0)
#define PG8_WAIT_V(n) asm volatile("s_waitcnt vmcnt(" #n ")" ::: "memory")
#define PG8_WAIT_L(n) asm volatile("s_waitcnt lgkmcnt(" #n ")" ::: "memory")
#define PG8_BAR __builtin_amdgcn_s_barrier()
#define PG8_SCHED __builtin_amdgcn_sched_barrier(0)
    Unit cur, nxt; int ui = 0;
    if (!S.next(0, cur)) return;
    f32x4 acc[2][2][4][2];
#pragma unroll
    for (int a = 0; a < 2; ++a)
#pragma unroll
        for (int b = 0; b < 2; ++b)
#pragma unroll
            for (int m = 0; m < 4; ++m)
#pragma unroll
                for (int n = 0; n < 2; ++n) acc[a][b][m][n] = (f32x4){0.f, 0.f, 0.f, 0.f};
    bf16x8 At[4][2], B0[2][2], B1[2][2];
    const char* cA = (const char*)g.A + (size_t)cur.pm * tstep; const char* cB = (const char*)g.Bt + (size_t)cur.pn * tstep;
    S.a_ready(cur);
    if constexpr (SP2) {
        PG8_STAGE(PG8_SB(0, 0), cB, voffB); PG8_STAGE(PG8_SB(0, 1), cB + hstep, voffB); PG8_STAGE(PG8_SA(0, 0), cA, voffA); PG8_STAGE(PG8_SA(0, 1), cA + hstep, voffA);
        if (wr == 1) PG8_BAR;
        PG8_WAIT_V(2); PG8_BAR;
        PG8_STAGE(PG8_SB(1, 0), cB + kstep, voffB); PG8_STAGE(PG8_SA(1, 0), cA + kstep, voffA); PG8_STAGE(PG8_SB(1, 1), cB + hstep + kstep, voffB);
        PG8_WAIT_V(6); PG8_BAR;
    } else {
        PG8_STAGE(PG8_SB(0, 0), cB, voffB); PG8_STAGE(PG8_SA(0, 0), cA, voffA); PG8_STAGE(PG8_SB(0, 1), cB + hstep, voffB); PG8_STAGE(PG8_SA(0, 1), cA + hstep, voffA);
        if (wr == 1) PG8_BAR;
        PG8_WAIT_V(4); PG8_BAR;
        PG8_STAGE(PG8_SB(1, 0), cB + kstep, voffB); PG8_STAGE(PG8_SA(1, 0), cA + kstep, voffA); PG8_STAGE(PG8_SB(1, 1), cB + hstep + kstep, voffB);
        PG8_WAIT_V(6); PG8_BAR;
    }
    for (;;) {
        const bool has_next = S.next(ui + 1, nxt);
        const char* nA = has_next ? (const char*)g.A + (size_t)nxt.pm * tstep : cA; const char* nB = has_next ? (const char*)g.Bt + (size_t)nxt.pn * tstep : cB;
        for (int t = 0; t < nt; t += 2) {
            const bool last = (t == nt - 2);
            const char* a1 = cA + (size_t)(t + 1) * kstep;
            const char* a2 = last ? nA : cA + (size_t)(t + 2) * kstep; const char* b2 = last ? nB : cB + (size_t)(t + 2) * kstep;
            const char* a3 = a2 + kstep; const char* b3 = b2 + kstep;
            if (last && has_next) S.a_ready(nxt);
            if constexpr (SP2) {
            PG8_LDB(B0, 0, 0); PG8_LDB(B1, 0, 1); PG8_SCHED; PG8_LDA(At, 0, 0); PG8_STAGE(PG8_SA(1, 1), a1 + hstep, voffA);
            PG8_WAIT_V(8); PG8_WAIT_L(0); PG8_BAR; PG8_MMA(0, 0, At, B0); PG8_MMA(0, 1, At, B1); PG8_BAR; PG8_SCHED;
            PG8_LDA(At, 0, 1); PG8_STAGE(PG8_SB(0, 0), b2, voffB); PG8_STAGE(PG8_SB(0, 1), b2 + hstep, voffB); PG8_STAGE(PG8_SA(0, 0), a2, voffA);
            PG8_WAIT_V(8); PG8_WAIT_L(0); PG8_BAR; PG8_MMA(1, 0, At, B0); PG8_MMA(1, 1, At, B1); PG8_BAR; PG8_SCHED;
            PG8_LDB(B0, 1, 0); PG8_LDB(B1, 1, 1); PG8_SCHED; PG8_LDA(At, 1, 0); PG8_STAGE(PG8_SA(0, 1), a2 + hstep, voffA);
            PG8_WAIT_V(8); PG8_WAIT_L(0); PG8_BAR; PG8_MMA(0, 0, At, B0); PG8_MMA(0, 1, At, B1); PG8_BAR; PG8_SCHED;
            PG8_LDA(At, 1, 1); PG8_STAGE(PG8_SB(1, 0), b3, voffB); PG8_STAGE(PG8_SB(1, 1), b3 + hstep, voffB); PG8_STAGE(PG8_SA(1, 0), a3, voffA);
            PG8_WAIT_V(8); PG8_WAIT_L(0); PG8_BAR; PG8_MMA(1, 0, At, B0); PG8_MMA(1, 1, At, B1); PG8_BAR; PG8_SCHED;
            } else {
            PG8_LDB(B0, 0, 0); PG8_SCHED; PG8_LDA(At, 0, 0); PG8_STAGE(PG8_SA(1, 1), a1 + hstep, voffA);
            PG8_WAIT_L(8); PG8_BAR; PG8_WAIT_L(0); PG8_MMA(0, 0, At, B0); PG8_BAR; PG8_SCHED;
            PG8_LDB(B1, 0, 1); PG8_STAGE(PG8_SB(0, 0), b2, voffB);
            PG8_BAR; PG8_WAIT_L(0); PG8_MMA(0, 1, At, B1); PG8_BAR;
            PG8_LDA(At, 0, 1); PG8_STAGE(PG8_SA(0, 0), a2, voffA);
            PG8_BAR; PG8_WAIT_L(0); PG8_MMA(1, 0, At, B0); PG8_BAR; PG8_SCHED;
            PG8_STAGE(PG8_SB(0, 1), b2 + hstep, voffB);
            PG8_WAIT_V(6); PG8_BAR; PG8_MMA(1, 1, At, B1); PG8_BAR;
            PG8_LDB(B0, 1, 0); PG8_SCHED; PG8_LDA(At, 1, 0); PG8_STAGE(PG8_SA(0, 1), a2 + hstep, voffA);
            PG8_WAIT_L(8); PG8_BAR; PG8_WAIT_L(0); PG8_MMA(0, 0, At, B0); PG8_BAR; PG8_SCHED;
            PG8_LDB(B1, 1, 1); PG8_STAGE(PG8_SB(1, 0), b3, voffB);
            PG8_BAR; PG8_WAIT_L(0); PG8_MMA(0, 1, At, B1); PG8_BAR;
            PG8_LDA(At, 1, 1); PG8_STAGE(PG8_SA(1, 0), a3, voffA);
            PG8_BAR; PG8_WAIT_L(0); PG8_MMA(1, 0, At, B0); PG8_BAR; PG8_SCHED;
            PG8_STAGE(PG8_SB(1, 1), b3 + hstep, voffB);
            PG8_WAIT_V(6); PG8_BAR; PG8_MMA(1, 1, At, B1); PG8_BAR;
            }
        }
        if constexpr (ALIGN_EPI) { if (wr == 0) PG8_BAR; }
        E(acc, cur, wr, wc, fr, fq, lds + STAGE_BYTES);
        if (!has_next) break;
#pragma unroll
        for (int a = 0; a < 2; ++a)
#pragma unroll
            for (int b = 0; b < 2; ++b)
#pragma unroll
                for (int m = 0; m < 4; ++m)
#pragma unroll
                    for (int n = 0; n < 2; ++n) acc[a][b][m][n] = (f32x4){0.f, 0.f, 0.f, 0.f};
        cur = nxt; cA = nA; cB = nB; ++ui;
        if constexpr (ALIGN_EPI) { if (wr == 1) PG8_BAR; }
    }
    PG8_WAIT_V(0);
    if constexpr (!ALIGN_EPI) { if (wr == 0) PG8_BAR; }
    PG8_BAR;
#undef PG8_SA
#undef PG8_SB
#undef PG8_STAGE
#undef PG8_LDA
#undef PG8_LDB
#undef PG8_MMA
#undef PG8_WAIT_V
#undef PG8_WAIT_L
#undef PG8_BAR
#undef PG8_SCHED
}
}

constexpr int BATCH = 8, SEQ = 4096, DM = 1024, M = BATCH * SEQ;
constexpr int NPROJ_LOG = 3272, NPROJ = 3328;
constexpr int DFF = 2816, NUP = 2 * DFF;
constexpr float EPS = 1e-6f;
constexpr int NWAVES = 8, NTHREADS = 512;
constexpr int NPHASE = 14;

typedef unsigned short bf16;
typedef float f32x4 __attribute__((ext_vector_type(4)));
typedef unsigned u32x4 __attribute__((ext_vector_type(4)));
typedef unsigned u32x2 __attribute__((ext_vector_type(2)));
#define LAS __attribute__((address_space(3)))
typedef short bf16x8_t __attribute__((ext_vector_type(8)));
typedef float f32x16 __attribute__((ext_vector_type(16)));
typedef short v4i16_t __attribute__((ext_vector_type(4)));

constexpr size_t MiB = 1u << 20;
constexpr size_t WS_CTL = 0;
constexpr size_t WS_COS = 1 * MiB, WS_SIN = WS_COS + 512 * 1024;
constexpr size_t WS_WIN = 2 * MiB;
constexpr size_t WS_WOUT = 9 * MiB;
constexpr size_t WS_WUP = 11 * MiB;
constexpr size_t WS_WDN = 22 * MiB;
constexpr size_t WS_HALO = 28 * MiB;
constexpr size_t WS_PART = 34 * MiB;
constexpr size_t WS_HN = 40 * MiB;
constexpr size_t WS_CAT = WS_HN;
constexpr size_t WS_BA = 104 * MiB;
constexpr size_t WS_BI = 144 * MiB;
constexpr size_t WS_IW = 180 * MiB;
constexpr size_t WS_ST = 181 * MiB;
constexpr size_t WS_PREV = 213 * MiB;
constexpr size_t WS_SEL = 229 * MiB;
constexpr size_t WS_KT = 245 * MiB;
constexpr size_t WS_VT = 277 * MiB;
constexpr size_t WS_HN2 = 309 * MiB;
constexpr size_t WS_BR = 373 * MiB;
constexpr size_t WS_SC = 245 * MiB;
constexpr size_t WS_MIX = 373 * MiB;
constexpr size_t WS_ACT = 104 * MiB;
constexpr size_t WS_FFN = 373 * MiB;
constexpr size_t WS_END = 512 * MiB;
constexpr size_t SC_BATCH = (size_t)128 * 128 * 528;

constexpr int LDS_BYTES = 147456;
constexpr int LDS_XCH = 131072;
constexpr int LDS_MISC = 143360;

__device__ __forceinline__ float bf2f(unsigned u) { return __uint_as_float(u << 16); }
__device__ __forceinline__ float bflo(unsigned w) { return __uint_as_float(w << 16); }
__device__ __forceinline__ float bfhi(unsigned w) { return __uint_as_float(w & 0xffff0000u); }
__device__ __forceinline__ unsigned f2bf(float f) { unsigned u = __float_as_uint(f); return (u + 0x7fffu + ((u >> 16) & 1u)) >> 16; }
__device__ __forceinline__ unsigned pk2(float lo, float hi) { return f2bf(lo) | (f2bf(hi) << 16); }
__device__ __forceinline__ float wave_sum(float v) {
#pragma unroll
    for (int o = 1; o < 64; o <<= 1) v += __shfl_xor(v, o);
    return v;
}
__device__ __forceinline__ float wave_max(float v) {
#pragma unroll
    for (int o = 1; o < 64; o <<= 1) v = fmaxf(v, __shfl_xor(v, o));
    return v;
}
__device__ __forceinline__ int wave_sum_i(int v) {
#pragma unroll
    for (int o = 1; o < 64; o <<= 1) v += __shfl_xor(v, o);
    return v;
}
__device__ __forceinline__ float silu_f(float x) { return x * __builtin_amdgcn_rcpf(1.0f + __builtin_amdgcn_exp2f(-1.4426950408889634f * x)); }
__device__ __forceinline__ float head_lg2(int h) { return log2f(1.0f - exp2f(-5.0f - (float)h)); }

struct Args { const float* in[11]; float* out; unsigned char* ws; int ph_lo, ph_hi, coop, pad; };

struct Frame {
    LAS unsigned char* lds;
    int tid, lane, wave, G, bid;
    const float *x, *g_mix_pre, *g_mix_post, *w_in, *w_out, *g_ffn_pre, *g_ffn_post, *w_up, *conv_w, *conv_b, *w_down;
    float* out; unsigned char* ws;
};

template <class CM>
__device__ __forceinline__ void p0_transpose_item(const float* W, int K, int ldw, int nlog, bf16* WT, LAS float* scr, int kb, int pb, int lane, CM cm) {
    const int k0 = 64 * kb, p0 = 32 * pb; const int q = lane & 31; const int c = cm(p0 + q);
#pragma unroll 8
    for (int i = 0; i < 32; ++i) { const int kk = 2 * i + (lane >> 5); scr[kk * 33 + q] = (c < nlog) ? W[(size_t)(k0 + kk) * ldw + c] : 0.f; }
    asm volatile("s_waitcnt lgkmcnt(0)" ::: "memory");
    const int c8 = lane & 7;
#pragma unroll
    for (int j = 0; j < 4; ++j) { const int n = (lane >> 3) + 8 * j; const LAS float* s = scr + (8 * c8) * 33 + n;
        u32x4 o; o.x = pk2(s[0 * 33], s[1 * 33]); o.y = pk2(s[2 * 33], s[3 * 33]); o.z = pk2(s[4 * 33], s[5 * 33]); o.w = pk2(s[6 * 33], s[7 * 33]);
        *(u32x4*)(WT + (size_t)(p0 + n) * K + k0 + 8 * c8) = o; }
    asm volatile("s_waitcnt lgkmcnt(0)" ::: "memory");
}
struct CmProj { __device__ __forceinline__ int operator()(int P) const { const int G = P >> 5, q = P & 31; return 64 * (G >> 1) + 16 * (G & 1) + (q & 15) + 32 * (q >> 4); } };
struct CmId   { __device__ __forceinline__ int operator()(int P) const { return P; } };
struct CmUp   { __device__ __forceinline__ int operator()(int P) const { return (P >> 8) * 128 + (P & 127) + ((P >> 7) & 1) * DFF; } };

__device__ __forceinline__ void sincos_d(float af, float& s, float& c) {
    const double a = (double)af; const double TWO_PI = 6.283185307179586476925286766559;
    const double n = rint(a * (1.0 / TWO_PI)); const double r = a - n * TWO_PI; const double r2 = r * r;
    double ps = 1.0 / 51090942171709440000.0 * -1.0;
    ps = ps * r2 + 1.0 / 121645100408832000.0;
    ps = ps * r2 - 1.0 / 355687428096000.0;
    ps = ps * r2 + 1.0 / 1307674368000.0;
    ps = ps * r2 - 1.0 / 6227020800.0;
    ps = ps * r2 + 1.0 / 39916800.0;
    ps = ps * r2 - 1.0 / 362880.0;
    ps = ps * r2 + 1.0 / 5040.0;
    ps = ps * r2 - 1.0 / 120.0;
    ps = ps * r2 + 1.0 / 6.0;
    ps = ps * r2 * -1.0 + 1.0;
    double pc = 1.0 / 1124000727777607680000.0;
    pc = pc * r2 - 1.0 / 2432902008176640000.0;
    pc = pc * r2 + 1.0 / 6402373705728000.0;
    pc = pc * r2 - 1.0 / 20922789888000.0;
    pc = pc * r2 + 1.0 / 87178291200.0;
    pc = pc * r2 - 1.0 / 479001600.0;
    pc = pc * r2 + 1.0 / 3628800.0;
    pc = pc * r2 - 1.0 / 40320.0;
    pc = pc * r2 + 1.0 / 720.0;
    pc = pc * r2 - 1.0 / 24.0;
    pc = pc * r2 + 0.5;
    pc = pc * r2 * -1.0 + 1.0;
    s = (float)(r * ps); c = (float)pc;
}

__device__ __forceinline__ void rms_row_to_bf16(const float* xrow, const float* g, bf16* orow, int lane) {
    const f32x4* xr = (const f32x4*)xrow + lane; const f32x4* gr = (const f32x4*)g + lane;
    f32x4 v[4]; float s = 0.f;
#pragma unroll
    for (int j = 0; j < 4; ++j) { v[j] = xr[64 * j]; s += (v[j].x * v[j].x + v[j].y * v[j].y) + (v[j].z * v[j].z + v[j].w * v[j].w); }
    const float rstd = 1.0f / sqrtf(wave_sum(s) * (1.f / DM) + EPS);
    unsigned long long* o8 = (unsigned long long*)orow + lane;
#pragma unroll
    for (int j = 0; j < 4; ++j) { const f32x4 gg = gr[64 * j];
        o8[64 * j] = (unsigned long long)pk2(v[j].x * rstd * gg.x, v[j].y * rstd * gg.y) | ((unsigned long long)pk2(v[j].z * rstd * gg.z, v[j].w * rstd * gg.w) << 32); }
}

__device__ __forceinline__ void phase_prologue(Frame& F) {
    LAS float* scr = (LAS float*)(F.lds + F.wave * 16384);
    const int gw = F.bid * NWAVES + F.wave, NGW = F.G * NWAVES;
    { float* COS = (float*)(F.ws + WS_COS); float* SIN = (float*)(F.ws + WS_SIN);
      for (int i = F.bid * NTHREADS + F.tid; i < SEQ * 32; i += F.G * NTHREADS) { const int pos = i >> 5, j = i & 31;
          const float inv = (float)exp2(-(double)j * (13.287712379549449 / 32.0));
          const float ang = (float)pos * inv; float s, c; sincos_d(ang, s, c); COS[i] = c; SIN[i] = s; } }
    constexpr int I_IN = (DM / 64) * (NPROJ / 32), I_OUT = (DM / 64) * (DM / 32), I_UP = (DM / 64) * (NUP / 32), I_DN = (DFF / 64) * (DM / 32);
    constexpr int NITEMS = I_IN + I_OUT + I_UP + I_DN;
    for (int it = gw; it < NITEMS; it += NGW) {
        int r = it;
        if (r < I_IN) { p0_transpose_item(F.w_in, DM, NPROJ_LOG, NPROJ_LOG, (bf16*)(F.ws + WS_WIN), scr, r / (NPROJ / 32), r % (NPROJ / 32), F.lane, CmProj()); continue; } r -= I_IN;
        if (r < I_OUT) { p0_transpose_item(F.w_out, DM, DM, DM, (bf16*)(F.ws + WS_WOUT), scr, r / (DM / 32), r % (DM / 32), F.lane, CmId()); continue; } r -= I_OUT;
        if (r < I_UP) { p0_transpose_item(F.w_up, DM, NUP, NUP, (bf16*)(F.ws + WS_WUP), scr, r / (NUP / 32), r % (NUP / 32), F.lane, CmUp()); continue; } r -= I_UP;
        p0_transpose_item(F.w_down, DFF, DM, DM, (bf16*)(F.ws + WS_WDN), scr, r / (DM / 32), r % (DM / 32), F.lane, CmId());
    }
    for (int m = gw; m < M; m += NGW) rms_row_to_bf16(F.x + (size_t)m * DM, F.g_mix_pre, (bf16*)(F.ws + WS_HN) + (size_t)m * DM, F.lane);
}

struct EpiProj {
    static constexpr bool PERM = false, AFTER_DRAIN = false;
    unsigned char* ws;
    __device__ __forceinline__ void operator()(const pg8::f32x4 (&acc)[2][2][4][2], const pg8::Unit& u, int wr, int wc, int fr, int fq, PG8_LAS unsigned char*) const {
        const float* COS = (const float*)(ws + WS_COS); const float* SIN = (const float*)(ws + WS_SIN);
        const int half = wc & 1, d0 = 16 * half + 4 * fq;
#pragma unroll
        for (int bj = 0; bj < 2; ++bj) {
            const int hb = 4 * u.pn + 2 * bj + (wc >> 1);
            if (hb >= 52) continue;
            const bool rope = (hb < 16) || (hb >= 32 && hb <= 40) || (hb >= 42 && hb <= 50);
            const float sc = ((hb >= 8 && hb < 16) || (hb >= 32 && hb < 40)) ? 0.125f : 1.0f;
            bf16* dst; int ld, col;
            if (hb < 32) { dst = (bf16*)(ws + WS_BR); ld = 2048; col = hb * 64; }
            else if (hb < 42) { dst = (bf16*)(ws + WS_BA); ld = 640; col = (hb - 32) * 64; }
            else { dst = (bf16*)(ws + WS_BI); ld = 576; col = (hb - 42) * 64; }
            bf16* tdst = nullptr;
            if (hb >= 8 && hb < 16) tdst = (bf16*)(ws + WS_KT) + (size_t)(hb - 8) * 64 * SEQ;
            if (hb >= 16 && hb < 24) tdst = (bf16*)(ws + WS_VT) + (size_t)(hb - 16) * 64 * SEQ;
#pragma unroll
            for (int ai = 0; ai < 2; ++ai)
#pragma unroll
                for (int m = 0; m < 4; ++m) {
                    const int row = u.pm * 256 + ai * 128 + wr * 64 + m * 16 + fr; const int pos = row & (SEQ - 1);
                    f32x4 v0 = acc[ai][bj][m][0], v1 = acc[ai][bj][m][1];
                    if (hb == 51) {
                        if (half == 0 && fq < 2) { float* iw = (float*)(ws + WS_IW) + (size_t)row * 8 + 4 * fq; *(f32x4*)iw = v0 * 0.044194173824159216f; }
                        continue;
                    }
                    if (rope) { const f32x4 cs = *(const f32x4*)(COS + pos * 32 + d0), sn = *(const f32x4*)(SIN + pos * 32 + d0);
                        const f32x4 o0 = v0 * cs - v1 * sn, o1 = v1 * cs + v0 * sn; v0 = o0 * sc; v1 = o1 * sc; }
                    u32x2 w0, w1; w0.x = pk2(v0[0], v0[1]); w0.y = pk2(v0[2], v0[3]); w1.x = pk2(v1[0], v1[1]); w1.y = pk2(v1[2], v1[3]);
                    bf16* p = dst + (size_t)row * ld + col + d0;
                    *(u32x2*)p = w0; *(u32x2*)(p + 32) = w1;
                    if (tdst) { bf16* tp = tdst + (size_t)(row >> 12) * (8 * 64 * SEQ) + (size_t)d0 * SEQ + pos;
                        const float zf = (hb < 16) ? exp2f(head_lg2(hb - 8) * (float)(127 - (pos & 127))) : 1.0f;
#pragma unroll
                        for (int e = 0; e < 4; ++e) { tp[e * SEQ] = (bf16)f2bf(v0[e] * zf); tp[(32 + e) * SEQ] = (bf16)f2bf(v1[e] * zf); } }
                }
        }
    }
};

__device__ __forceinline__ void phase_ret_state(Frame& F) {
    const bf16* KT = (const bf16*)(F.ws + WS_KT); const bf16* VT = (const bf16*)(F.ws + WS_VT); float* ST = (float*)(F.ws + WS_ST);
    const int total = 2048 * 4096;
    for (int o = F.bid * NTHREADS + F.tid; o < total; o += F.G * NTHREADS) {
        const int unit = o >> 12, v = (o >> 6) & 63, k = o & 63, b = unit >> 8, n = (unit >> 3) & 31, h = unit & 7;
        const float lg = head_lg2(h);
        const u32x4* vp = (const u32x4*)(VT + ((size_t)((b * 8 + h) * 64 + v)) * SEQ + n * 128);
        const u32x4* kp = (const u32x4*)(KT + ((size_t)((b * 8 + h) * 64 + k)) * SEQ + n * 128);
        float acc = 0.f;
        for (int m8 = 0; m8 < 16; ++m8) { const u32x4 a = vp[m8], c = kp[m8];
#pragma unroll
            for (int j = 0; j < 4; ++j) { const int m = m8 * 8 + 2 * j;
                acc += bflo(a[j]) * bflo(c[j]) * exp2f(lg * (float)(127 - m)); acc += bfhi(a[j]) * bfhi(c[j]) * exp2f(lg * (float)(126 - m)); } }
        ST[o] = acc;
    }
}
__device__ __forceinline__ void phase_ret_scan(Frame& F) {
    const float* ST = (const float*)(F.ws + WS_ST); bf16* PV = (bf16*)(F.ws + WS_PREV);
    for (int e = F.bid * NTHREADS + F.tid; e < 8 * 8 * 4096; e += F.G * NTHREADS) {
        const int b = e >> 15, h = (e >> 12) & 7, vk = e & 4095; const float dec = exp2f(128.0f * head_lg2(h)); float R = 0.f;
        for (int n = 0; n < 32; ++n) { const size_t idx = ((size_t)((b * 32 + n) * 8 + h) << 12) + vk; PV[idx] = (bf16)f2bf(R); R = dec * R + ST[idx]; }
    }
}
__device__ __forceinline__ void phase_ret_out(Frame& F) {
    const bf16* BR = (const bf16*)(F.ws + WS_BR); const bf16* PV = (const bf16*)(F.ws + WS_PREV); bf16* CAT = (bf16*)(F.ws + WS_CAT);
    const int gw = F.bid * NWAVES + F.wave, NGW = F.G * NWAVES, lane = F.lane;
    for (int row = gw; row < M * 8; row += NGW) {
        const int tok = row >> 3, h = row & 7, t = tok & (SEQ - 1), n = t >> 7, c = t & 127, r0 = tok - c, b = tok >> 12;
        const float lg = head_lg2(h);
        float q[64];
        { const u32x4* qp = (const u32x4*)(BR + (size_t)tok * 2048 + h * 64);
#pragma unroll
          for (int i = 0; i < 8; ++i) { const u32x4 w = qp[i];
#pragma unroll
              for (int j = 0; j < 4; ++j) { q[i * 8 + 2 * j] = bflo(w[j]); q[i * 8 + 2 * j + 1] = bfhi(w[j]); } } }
        float s_lo = 0.f, s_hi = 0.f;
#pragma unroll
        for (int part = 0; part < 2; ++part) { const int m = lane + 64 * part;
            if (m <= c) { const u32x4* kp = (const u32x4*)(BR + (size_t)(r0 + m) * 2048 + 512 + h * 64); float d = 0.f;
#pragma unroll
                for (int i = 0; i < 8; ++i) { const u32x4 w = kp[i];
#pragma unroll
                    for (int j = 0; j < 4; ++j) { d += q[i * 8 + 2 * j] * bflo(w[j]); d += q[i * 8 + 2 * j + 1] * bfhi(w[j]); } }
                d *= exp2f(lg * (float)(c - m)); if (part == 0) s_lo = d; else s_hi = d; } }
        float o = 0.f;
        for (int m = 0; m <= c; ++m) { const float sm = __shfl(m < 64 ? s_lo : s_hi, m & 63); o += sm * bf2f(BR[(size_t)(r0 + m) * 2048 + 1024 + h * 64 + lane]); }
        { const int unit = (b * 32 + n) * 8 + h; const u32x4* pp = (const u32x4*)(PV + ((size_t)unit << 12) + lane * 64); float cr = 0.f;
#pragma unroll
          for (int i = 0; i < 8; ++i) { const u32x4 w = pp[i];
#pragma unroll
              for (int j = 0; j < 4; ++j) { cr += q[i * 8 + 2 * j] * bflo(w[j]); cr += q[i * 8 + 2 * j + 1] * bfhi(w[j]); } }
          o += cr * exp2f(lg * (float)(c + 1)); }
        const float ss = wave_sum(o * o); o *= 1.0f / sqrtf(ss * (1.f / 64.f) + EPS);
        const float g = bf2f(BR[(size_t)tok * 2048 + 1536 + h * 64 + lane]); o *= silu_f(g);
        CAT[(size_t)tok * 1024 + h * 64 + lane] = (bf16)f2bf(o);
    }
}
__device__ __forceinline__ void phase_ret_state_mfma(Frame& F) {
    const bf16* KT = (const bf16*)(F.ws + WS_KT); const bf16* VT = (const bf16*)(F.ws + WS_VT); float* ST = (float*)(F.ws + WS_ST);
    const int gw = F.bid * NWAVES + F.wave, NGW = F.G * NWAVES, lane = F.lane, r = lane & 31, hh = lane >> 5;
    for (int unit = gw; unit < 2048; unit += NGW) {
        const int b = unit >> 8, n = (unit >> 3) & 31, h = unit & 7;
        const bf16* vp = VT + ((size_t)((b * 8 + h) * 64 + r)) * SEQ + n * 128 + 8 * hh;
        const bf16* kp = KT + ((size_t)((b * 8 + h) * 64 + r)) * SEQ + n * 128 + 8 * hh;
        f32x16 acc[2][2];
#pragma unroll
        for (int a = 0; a < 2; ++a)
#pragma unroll
            for (int c = 0; c < 2; ++c)
#pragma unroll
                for (int i = 0; i < 16; ++i) acc[a][c][i] = 0.f;
#pragma unroll
        for (int s = 0; s < 8; ++s) {
            bf16x8_t va[2], kb[2];
#pragma unroll
            for (int x = 0; x < 2; ++x) { va[x] = *(const bf16x8_t*)(vp + (size_t)32 * x * SEQ + 16 * s); kb[x] = *(const bf16x8_t*)(kp + (size_t)32 * x * SEQ + 16 * s); }
#pragma unroll
            for (int a = 0; a < 2; ++a)
#pragma unroll
                for (int c = 0; c < 2; ++c) acc[a][c] = __builtin_amdgcn_mfma_f32_32x32x16_bf16(va[a], kb[c], acc[a][c], 0, 0, 0);
        }
        float* o = ST + ((size_t)unit << 12);
#pragma unroll
        for (int a = 0; a < 2; ++a)
#pragma unroll
            for (int c = 0; c < 2; ++c)
#pragma unroll
                for (int i = 0; i < 16; ++i) o[(32 * a + (i & 3) + 8 * (i >> 2) + 4 * hh) * 64 + 32 * c + r] = acc[a][c][i];
    }
}
__device__ __forceinline__ void phase_ret_out_mfma(Frame& F) {
    const bf16* BR = (const bf16*)(F.ws + WS_BR); const bf16* VT = (const bf16*)(F.ws + WS_VT); const bf16* PV = (const bf16*)(F.ws + WS_PREV); bf16* CAT = (bf16*)(F.ws + WS_CAT);
    const int gw = F.bid * NWAVES + F.wave, NGW = F.G * NWAVES, lane = F.lane, r = lane & 31, hh = lane >> 5;
    for (int unit = gw; unit < 2048; unit += NGW) {
        const int b = unit >> 8, n = (unit >> 3) & 31, h = unit & 7; const int r0 = b * SEQ + n * 128; const float lg = head_lg2(h);
        const bf16* vtp = VT + ((size_t)((b * 8 + h) * 64 + r)) * SEQ + n * 128 + 4 * hh;
        const bf16* pvp = PV + ((size_t)unit << 12) + r * 64 + 8 * hh;
#pragma unroll 1
        for (int ci = 0; ci < 4; ++ci) {
            const int c = 32 * ci + r;
            bf16x8_t qf[4];
#pragma unroll
            for (int s = 0; s < 4; ++s) qf[s] = *(const bf16x8_t*)(BR + (size_t)(r0 + c) * 2048 + h * 64 + 16 * s + 8 * hh);
            f32x16 o[2];
#pragma unroll
            for (int vt = 0; vt < 2; ++vt) {
#pragma unroll
                for (int i = 0; i < 16; ++i) o[vt][i] = 0.f;
#pragma unroll
                for (int s = 0; s < 4; ++s) { const bf16x8_t pa = *(const bf16x8_t*)(pvp + 32 * vt * 64 + 16 * s); o[vt] = __builtin_amdgcn_mfma_f32_32x32x16_bf16(pa, qf[s], o[vt], 0, 0, 0); }
            }
            { const float xi = exp2f(lg * (float)(c + 1));
#pragma unroll
              for (int vt = 0; vt < 2; ++vt)
#pragma unroll
                  for (int i = 0; i < 16; ++i) o[vt][i] *= xi; }
#pragma unroll 1
            for (int mi = 0; mi <= ci; ++mi) {
                f32x16 st;
#pragma unroll
                for (int i = 0; i < 16; ++i) st[i] = 0.f;
#pragma unroll
                for (int s = 0; s < 4; ++s) { const bf16x8_t ka = *(const bf16x8_t*)(BR + (size_t)(r0 + 32 * mi + r) * 2048 + 512 + h * 64 + 16 * s + 8 * hh);
                    st = __builtin_amdgcn_mfma_f32_32x32x16_bf16(ka, qf[s], st, 0, 0, 0); }
#pragma unroll
                for (int i = 0; i < 16; ++i) { const int m = 32 * mi + (i & 3) + 8 * (i >> 2) + 4 * hh; const int dm = c - m; st[i] = (dm >= 0) ? st[i] * exp2f(lg * (float)dm) : 0.f; }
#pragma unroll
                for (int s2 = 0; s2 < 2; ++s2) {
                    u32x4 pw; pw.x = pk2(st[8 * s2 + 0], st[8 * s2 + 1]); pw.y = pk2(st[8 * s2 + 2], st[8 * s2 + 3]); pw.z = pk2(st[8 * s2 + 4], st[8 * s2 + 5]); pw.w = pk2(st[8 * s2 + 6], st[8 * s2 + 7]);
                    const bf16x8_t pb = __builtin_bit_cast(bf16x8_t, pw);
#pragma unroll
                    for (int vt = 0; vt < 2; ++vt) { const bf16* vp = vtp + (size_t)32 * vt * SEQ + 32 * mi + 16 * s2;
                        const u32x2 lo = *(const u32x2*)vp, hi2 = *(const u32x2*)(vp + 8);
                        const bf16x8_t va = __builtin_bit_cast(bf16x8_t, (u32x4){lo.x, lo.y, hi2.x, hi2.y});
                        o[vt] = __builtin_amdgcn_mfma_f32_32x32x16_bf16(va, pb, o[vt], 0, 0, 0); }
                }
            }
            float ss = 0.f;
#pragma unroll
            for (int vt = 0; vt < 2; ++vt)
#pragma unroll
                for (int i = 0; i < 16; ++i) ss += o[vt][i] * o[vt][i];
            ss += __shfl_xor(ss, 32);
            const float rstd = 1.0f / sqrtf(ss * (1.f / 64.f) + EPS);
            const bf16* gp = BR + (size_t)(r0 + c) * 2048 + 1536 + h * 64 + 4 * hh; bf16* op = CAT + (size_t)(r0 + c) * 1024 + h * 64 + 4 * hh;
#pragma unroll
            for (int vt = 0; vt < 2; ++vt)
#pragma unroll
                for (int g4 = 0; g4 < 4; ++g4) { const u32x2 gw2 = *(const u32x2*)(gp + 32 * vt + 8 * g4);
                    const float g0 = bflo(gw2.x), g1 = bfhi(gw2.x), g2 = bflo(gw2.y), g3 = bfhi(gw2.y);
                    u32x2 ow; ow.x = pk2(o[vt][4 * g4] * rstd * silu_f(g0), o[vt][4 * g4 + 1] * rstd * silu_f(g1)); ow.y = pk2(o[vt][4 * g4 + 2] * rstd * silu_f(g2), o[vt][4 * g4 + 3] * rstd * silu_f(g3));
                    *(u32x2*)(op + 32 * vt + 8 * g4) = ow; }
        }
    }
}
__device__ __forceinline__ size_t sc_off(int b, int qb) { return (size_t)b * SC_BATCH + (size_t)16384 * (size_t)(qb * (qb + 1) / 2); }
__device__ __forceinline__ void phase_idx_scores(Frame& F) {
    const bf16* BI = (const bf16*)(F.ws + WS_BI); const float* IW = (const float*)(F.ws + WS_IW); float* SC = (float*)(F.ws + WS_SC);
    const int gw = F.bid * NWAVES + F.wave, NGW = F.G * NWAVES, lane = F.lane;
    for (int task = gw; task < 8 * 1056; task += NGW) {
        const int b = task & 7; int r = task >> 3; int qb = 0; while (r >= 2 * (qb + 1)) { r -= 2 * (qb + 1); ++qb; } const int kc = r;
        const int s = kc * 64 + lane; const int pitch = (qb + 1) * 128;
        unsigned kr[32];
        { const u32x4* kp = (const u32x4*)(BI + (size_t)(b * SEQ + s) * 576 + 512);
#pragma unroll
          for (int i = 0; i < 8; ++i) { const u32x4 w = kp[i]; kr[4 * i] = w.x; kr[4 * i + 1] = w.y; kr[4 * i + 2] = w.z; kr[4 * i + 3] = w.w; } }
        float* scb = SC + sc_off(b, qb) + s;
        for (int tq = 0; tq < 128; ++tq) { const int tok = b * SEQ + qb * 128 + tq; float sc = 0.f;
            const f32x4 w0 = *(const f32x4*)(IW + (size_t)tok * 8), w1 = *(const f32x4*)(IW + (size_t)tok * 8 + 4);
#pragma unroll
            for (int h = 0; h < 8; ++h) { const u32x4* qp = (const u32x4*)(BI + (size_t)tok * 576 + h * 64); float d = 0.f;
#pragma unroll
                for (int i = 0; i < 8; ++i) { const u32x4 w = qp[i];
#pragma unroll
                    for (int j = 0; j < 4; ++j) { d += bflo(w[j]) * bflo(kr[4 * i + j]); d += bfhi(w[j]) * bfhi(kr[4 * i + j]); } }
                const float wh = h < 4 ? w0[h & 3] : w1[h & 3]; sc += wh * fmaxf(d, 0.f); }
            scb[(size_t)tq * pitch] = sc; }
    }
}
__device__ __forceinline__ void phase_idx_scores_mfma(Frame& F) {
    const bf16* BI = (const bf16*)(F.ws + WS_BI); const float* IW = (const float*)(F.ws + WS_IW); float* SC = (float*)(F.ws + WS_SC);
    const int lane = F.lane, r = lane & 31, hh = lane >> 5, qs = F.wave & 1, kq = F.wave >> 1;
    for (int pairi = F.bid; pairi < 256; pairi += F.G) {
        const int b = pairi & 7, p = pairi >> 3;
#pragma unroll 1
        for (int hf = 0; hf < 2; ++hf) {
            const int qt = hf ? 63 - p : p; const int tok0 = b * SEQ + qt * 64;
            __syncthreads();
            { const int row = F.tid >> 3, ch = F.tid & 7; const u32x4* src = (const u32x4*)(BI + (size_t)(tok0 + row) * 576 + ch * 64); LAS u32x4* dst = (LAS u32x4*)(F.lds + row * 1040 + ch * 128);
#pragma unroll
              for (int i = 0; i < 8; ++i) dst[i] = src[i];
              if (F.tid < 128) *(LAS f32x4*)(F.lds + 66560 + F.tid * 16) = *(const f32x4*)(IW + (size_t)tok0 * 8 + F.tid * 4); }
            __syncthreads();
            const LAS float* wl = (const LAS float*)(F.lds + 66560) + (32 * qs + r) * 8;
            const int pitch = ((qt >> 1) + 1) * 128;
            float* scrow = SC + sc_off(b, qt >> 1) + (size_t)((qt & 1) * 64 + 32 * qs + r) * pitch;
            const LAS unsigned char* qbase = F.lds + (32 * qs + r) * 1040 + hh * 16;
            const bf16* kbase = BI + (size_t)(b * SEQ + r) * 576 + 512 + 8 * hh;
            bf16x8_t kf[2][4], kn[2][4];
#define IDX_LOADK(dst, k0) do { _Pragma("unroll") for (int tl = 0; tl < 2; ++tl) _Pragma("unroll") for (int s = 0; s < 4; ++s) dst[tl][s] = *(const bf16x8_t*)(kbase + (size_t)((k0) + 32 * tl) * 576 + 16 * s); } while (0)
            int k0 = 64 * kq; const int klim = 64 * qt;
            if (k0 <= klim) IDX_LOADK(kf, k0);
#pragma unroll 1
            for (; k0 <= klim; k0 += 256) {
                const bool more = (k0 + 256) <= klim;
                if (more) IDX_LOADK(kn, k0 + 256);
                f32x16 sc0, sc1;
#pragma unroll
                for (int i = 0; i < 16; ++i) { sc0[i] = 0.f; sc1[i] = 0.f; }
#pragma unroll 1
                for (int h = 0; h < 8; ++h) {
                    const float wh = wl[h];
                    bf16x8_t qf[4];
#pragma unroll
                    for (int s = 0; s < 4; ++s) qf[s] = *(const LAS bf16x8_t*)(qbase + h * 128 + s * 32);
                    f32x16 a0, a1;
#pragma unroll
                    for (int i = 0; i < 16; ++i) { a0[i] = 0.f; a1[i] = 0.f; }
#pragma unroll
                    for (int s = 0; s < 4; ++s) { a0 = __builtin_amdgcn_mfma_f32_32x32x16_bf16(kf[0][s], qf[s], a0, 0, 0, 0); a1 = __builtin_amdgcn_mfma_f32_32x32x16_bf16(kf[1][s], qf[s], a1, 0, 0, 0); }
#pragma unroll
                    for (int i = 0; i < 16; ++i) { sc0[i] = fmaf(wh, fmaxf(a0[i], 0.f), sc0[i]); sc1[i] = fmaf(wh, fmaxf(a1[i], 0.f), sc1[i]); }
                }
#pragma unroll
                for (int g = 0; g < 4; ++g) {
                    *(f32x4*)(scrow + k0 + 8 * g + 4 * hh) = (f32x4){sc0[4 * g], sc0[4 * g + 1], sc0[4 * g + 2], sc0[4 * g + 3]};
                    *(f32x4*)(scrow + k0 + 32 + 8 * g + 4 * hh) = (f32x4){sc1[4 * g], sc1[4 * g + 1], sc1[4 * g + 2], sc1[4 * g + 3]}; }
                if (more) {
#pragma unroll
                    for (int tl = 0; tl < 2; ++tl)
#pragma unroll
                        for (int s = 0; s < 4; ++s) kf[tl][s] = kn[tl][s]; }
            }
#undef IDX_LOADK
        }
    }
    __syncthreads();
}
#define SEL_POS(p) ((((p) & 15) << 4) | ((p) >> 4))
constexpr int SEL_CAP = 512;
__device__ __forceinline__ float vmin_s(float a, float b) { float r; asm("v_min_f32_e32 %0, %1, %2" : "=v"(r) : "v"(a), "v"(b)); return r; }
__device__ __forceinline__ float vmax_s(float a, float b) { float r; asm("v_max_f32_e32 %0, %1, %2" : "=v"(r) : "v"(a), "v"(b)); return r; }
__device__ __forceinline__ int mbcnt64(unsigned long long m) { return (int)__builtin_amdgcn_mbcnt_hi((unsigned)(m >> 32), __builtin_amdgcn_mbcnt_lo((unsigned)m, 0u)); }
__device__ __forceinline__ void select_row(const float* rowp, int L, bf16* out, int lane, unsigned long long lt, LAS unsigned* hist, LAS float* cval, LAS int* cidx) {
    const int nch = (L + 255) >> 8;
    float x[64]; float mn = 3.0e38f, mx = -3.0e38f;
    const float qnan = __uint_as_float(0x7fc00000u);
#pragma unroll
    for (int c = 0; c < 16; ++c) { if (c < nch) { const f32x4 v = *(const f32x4*)(rowp + 256 * c + 4 * lane);
#pragma unroll
        for (int e = 0; e < 4; ++e) x[4 * c + e] = v[e];
        if (c == nch - 1) {
#pragma unroll
            for (int e = 0; e < 4; ++e) x[4 * c + e] = (256 * c + 4 * lane + e < L) ? x[4 * c + e] : qnan; }
#pragma unroll
        for (int e = 0; e < 4; ++e) { mn = vmin_s(mn, x[4 * c + e]); mx = vmax_s(mx, x[4 * c + e]); } } }
#pragma unroll
    for (int o = 1; o < 64; o <<= 1) { mn = vmin_s(mn, __shfl_xor(mn, o)); mx = vmax_s(mx, __shfl_xor(mx, o)); }
    const float scale = (mx > mn) ? 2047.99f / (mx - mn) : 0.f; const float off = -mn * scale;
#pragma unroll
    for (int i = 0; i < 8; ++i) *(LAS u32x4*)(hist + 32 * lane + 4 * i) = (u32x4){0u, 0u, 0u, 0u};
#pragma unroll
    for (int c = 0; c < 16; ++c) { if (c < nch) {
#pragma unroll
        for (int e = 0; e < 4; ++e) { unsigned bn = (unsigned)fmaf(x[4 * c + e], scale, off); bn = bn > 2047u ? 2047u : bn;
            if (c < nch - 1 || (256 * c + 4 * lane + e < L)) __hip_atomic_fetch_add(hist + bn, 1u, __ATOMIC_RELAXED, __HIP_MEMORY_SCOPE_WORKGROUP); } } }
    unsigned sl = 0u;
#pragma unroll
    for (int i = 0; i < 8; ++i) { const u32x4 w = *(const LAS u32x4*)(hist + 32 * lane + 4 * i); sl += (w.x + w.y) + (w.z + w.w); }
    unsigned I = sl;
#pragma unroll
    for (int o = 1; o < 64; o <<= 1) { const unsigned t2 = __shfl_down(I, o); if (lane + o < 64) I += t2; }
    const unsigned long long mk = __ballot(I >= 256u);
    const int lstar = 63 - __clzll(mk);
    unsigned cum = (unsigned)__shfl((int)(I - sl), lstar); int bti = -1; unsigned abv = 0u;
#pragma unroll
    for (int i = 7; i >= 0; --i) { const u32x4 w = *(const LAS u32x4*)(hist + 32 * lstar + 4 * i);
#pragma unroll
        for (int k = 3; k >= 0; --k) { const unsigned c2 = cum + w[k]; if (bti < 0 && c2 >= 256u) { bti = 32 * lstar + 4 * i + k; abv = cum; } cum = c2; } }
    const unsigned bt = (unsigned)bti; const int above = (int)abv;
    const int nc = (int)hist[bt]; const int need = 256 - above;
    if (nc > SEL_CAP) {
#pragma unroll
        for (int j = 0; j < 64; ++j) { const float f = x[j]; unsigned bits = __float_as_uint(f); if (f == 0.f) bits = 0u;
            const unsigned key = (bits & 0x80000000u) ? ~bits : (bits | 0x80000000u); x[j] = __uint_as_float((f != f || j >= 4 * nch) ? 0u : key); }
        unsigned T = 0u;
        for (int bit = 31; bit >= 0; --bit) { const unsigned cand = T | (1u << bit); int cnt = 0;
#pragma unroll
            for (int j = 0; j < 64; ++j) cnt += __popcll(__ballot(__float_as_uint(x[j]) >= cand));
            if (cnt >= 256) T = cand; }
        int ngt = 0;
#pragma unroll
        for (int j = 0; j < 64; ++j) ngt += __popcll(__ballot(__float_as_uint(x[j]) > T));
        const int need_eq = 256 - ngt; int pos = 0, eqc = 0;
#pragma unroll
        for (int c = 0; c < 16; ++c) { if (c < nch) {
            unsigned long long me[4]; int mine = 0, base = eqc;
#pragma unroll
            for (int e = 0; e < 4; ++e) { me[e] = __ballot(__float_as_uint(x[4 * c + e]) == T); base += mbcnt64(me[e]); eqc += __popcll(me[e]); }
#pragma unroll
            for (int e = 0; e < 4; ++e) { const unsigned kv = __float_as_uint(x[4 * c + e]); const bool eq = kv == T;
                const bool take = (kv > T) || (eq && (base + mine) < need_eq); mine += eq ? 1 : 0;
                const unsigned long long mt = __ballot(take);
                if (take) { const int pp = pos + mbcnt64(mt); out[SEL_POS(pp)] = (bf16)(256 * c + 4 * lane + e); }
                pos += __popcll(mt); } } }
        return;
    }
    int pos = 0, cpos = 0;
#pragma unroll
    for (int c = 0; c < 16; ++c) { if (c < nch) {
#pragma unroll
        for (int e = 0; e < 4; ++e) { const float xv = x[4 * c + e]; unsigned bn = (unsigned)fmaf(xv, scale, off); bn = bn > 2047u ? 2047u : bn;
            const bool ok = xv == xv;
            const bool sel = ok && bn > bt, cd = ok && bn == bt;
            const unsigned long long ms = __ballot(sel), mc = __ballot(cd);
            if (sel) { const int pp = pos + mbcnt64(ms); out[SEL_POS(pp)] = (bf16)(256 * c + 4 * lane + e); }
            pos += __popcll(ms);
            if (mc != 0ull) { if (cd) { const int ci = cpos + mbcnt64(mc); cval[ci] = xv; cidx[ci] = 256 * c + 4 * lane + e; } cpos += __popcll(mc); } } } }
    for (int i0 = 0; i0 < nc; i0 += 64) { const int i = i0 + lane; const bool act = i < nc; const float vi = act ? cval[i] : 0.f; const int si = act ? cidx[i] : 0; int rank = 0;
        for (int j = 0; j < nc; ++j) { const float vj = cval[j]; const int sj = cidx[j]; rank += (vj > vi || (vj == vi && sj < si)) ? 1 : 0; }
        const bool take = act && rank < need; const unsigned long long mt = __ballot(take);
        if (take) { const int pp = pos + mbcnt64(mt); out[SEL_POS(pp)] = (bf16)si; }
        pos += __popcll(mt); }
}
__device__ __forceinline__ void phase_select(Frame& F) {
    const float* SC = (const float*)(F.ws + WS_SC); bf16* SEL = (bf16*)(F.ws + WS_SEL);
    const int gw = F.bid * NWAVES + F.wave, NGW = F.G * NWAVES, lane = F.lane;
    const unsigned long long lt = (1ull << lane) - 1ull;
    LAS unsigned* hist = (LAS unsigned*)(F.lds + F.wave * 16384); LAS float* cval = (LAS float*)(F.lds + F.wave * 16384 + 8192); LAS int* cidx = (LAS int*)(F.lds + F.wave * 16384 + 8192 + 4 * SEL_CAP);
    for (int task = gw; task < 8 * 2048; task += NGW) {
        const int b = task >> 11, p = task & 2047;
#pragma unroll 1
        for (int hf = 0; hf < 2; ++hf) { const int t = hf ? 4095 - p : p;
            if (t < 256) { bf16* o = SEL + (size_t)(b * SEQ + t) * 256;
#pragma unroll
                for (int i = 0; i < 4; ++i) { const int pp = lane + 64 * i; o[SEL_POS(pp)] = (bf16)(pp <= t ? pp : 0); }
                continue; }
            const int qb = t >> 7, pitch = (qb + 1) * 128;
            select_row(SC + sc_off(b, qb) + (size_t)(t & 127) * pitch, t + 1, SEL + (size_t)(b * SEQ + t) * 256, lane, lt, hist, cval, cidx); }
    }
}
__device__ __forceinline__ void phase_attn(Frame& F) {
    const bf16* BA = (const bf16*)(F.ws + WS_BA); const bf16* SEL = (const bf16*)(F.ws + WS_SEL); bf16* CAT = (bf16*)(F.ws + WS_CAT);
    const int gw = F.bid * NWAVES + F.wave, NGW = F.G * NWAVES, lane = F.lane;
    LAS float* pl = (LAS float*)(F.lds + F.wave * 16384);
    LAS int* il = (LAS int*)(F.lds + F.wave * 16384 + 8192);
    for (int tok = gw; tok < M; tok += NGW) {
        const int t = tok & (SEQ - 1), b = tok >> 12; const int nk = t + 1 < 256 ? t + 1 : 256;
        float lg[8][4]; int idx[4];
#pragma unroll
        for (int i = 0; i < 4; ++i) { const int j = lane + 64 * i; idx[i] = (t < 256) ? (j < nk ? j : 0) : (int)SEL[(size_t)tok * 256 + j];
            unsigned kr[32]; { const u32x4* kp = (const u32x4*)(BA + (size_t)(b * SEQ + idx[i]) * 640 + 512);
#pragma unroll
                for (int c = 0; c < 8; ++c) { const u32x4 w = kp[c]; kr[4 * c] = w.x; kr[4 * c + 1] = w.y; kr[4 * c + 2] = w.z; kr[4 * c + 3] = w.w; } }
#pragma unroll
            for (int h = 0; h < 8; ++h) { const u32x4* qp = (const u32x4*)(BA + (size_t)tok * 640 + h * 64); float d = 0.f;
#pragma unroll
                for (int c = 0; c < 8; ++c) { const u32x4 w = qp[c];
#pragma unroll
                    for (int e = 0; e < 4; ++e) { d += bflo(w[e]) * bflo(kr[4 * c + e]); d += bfhi(w[e]) * bfhi(kr[4 * c + e]); } }
                lg[h][i] = (j < nk) ? d : -1e30f; } }
#pragma unroll
        for (int h = 0; h < 8; ++h) { float mx = fmaxf(fmaxf(lg[h][0], lg[h][1]), fmaxf(lg[h][2], lg[h][3])); mx = wave_max(mx); float e[4], sm = 0.f;
#pragma unroll
            for (int i = 0; i < 4; ++i) { e[i] = (lane + 64 * i < nk) ? __expf(lg[h][i] - mx) : 0.f; sm += e[i]; }
            sm = wave_sum(sm); const float inv = 1.0f / sm;
#pragma unroll
            for (int i = 0; i < 4; ++i) pl[(lane + 64 * i) * 8 + h] = e[i] * inv; }
#pragma unroll
        for (int i = 0; i < 4; ++i) il[lane + 64 * i] = idx[i];
        asm volatile("s_waitcnt lgkmcnt(0)" ::: "memory");
        float o[8];
#pragma unroll
        for (int h = 0; h < 8; ++h) o[h] = 0.f;
        for (int j = 0; j < nk; ++j) { const int kidx = il[j]; const float v = bf2f(BA[(size_t)(b * SEQ + kidx) * 640 + 576 + lane]);
            const f32x4 p0 = *(const LAS f32x4*)(pl + j * 8), p1 = *(const LAS f32x4*)(pl + j * 8 + 4);
            o[0] += p0.x * v; o[1] += p0.y * v; o[2] += p0.z * v; o[3] += p0.w * v; o[4] += p1.x * v; o[5] += p1.y * v; o[6] += p1.z * v; o[7] += p1.w * v; }
#pragma unroll
        for (int h = 0; h < 8; ++h) CAT[(size_t)tok * 1024 + 512 + h * 64 + lane] = (bf16)f2bf(o[h]);
        asm volatile("s_waitcnt lgkmcnt(0)" ::: "memory");
    }
}

__device__ __forceinline__ void phase_attn_mfma(Frame& F) {
    const bf16* BA = (const bf16*)(F.ws + WS_BA); const bf16* SEL = (const bf16*)(F.ws + WS_SEL); bf16* CAT = (bf16*)(F.ws + WS_CAT);
    const int lane = F.lane, li = lane & 15, g = lane >> 4, r8 = lane >> 3, c8 = lane & 7;
    LAS unsigned char* vl = F.lds + F.wave * 16384;
    const int b = F.bid & 7, wslot = (F.bid >> 3) * NWAVES + F.wave, nslot = (F.G >> 3) * NWAVES;
    const char* bab = (const char*)(BA + (size_t)b * SEQ * 640);
    const unsigned koff = (512 + 8 * g) * 2, voff = (576 + 8 * c8) * 2;
    u32x4 ik[2], iv[2][2], nik[2];
    const unsigned ioffk = li * 32u, ioffv = r8 * 32u;
#define ATT_LOADIK(dk, tt) do { const char* sp_ = (const char*)SEL + (size_t)(b * SEQ + (tt)) * 512; dk[0] = *(const u32x4*)(sp_ + ioffk); dk[1] = *(const u32x4*)(sp_ + (ioffk + 16u)); } while (0)
#define ATT_LOADIV(dv, tt) do { const char* sp_ = (const char*)SEL + (size_t)(b * SEQ + (tt)) * 512; \
        dv[0][0] = *(const u32x4*)(sp_ + ioffv); dv[0][1] = *(const u32x4*)(sp_ + (ioffv + 16u)); dv[1][0] = *(const u32x4*)(sp_ + (ioffv + 256u)); dv[1][1] = *(const u32x4*)(sp_ + (ioffv + 272u)); } while (0)
#pragma unroll
    for (int z = 0; z < 2; ++z) { ik[z] = (u32x4){0u, 0u, 0u, 0u}; iv[0][z] = ik[z]; iv[1][z] = ik[z]; nik[z] = ik[z]; }
    if (wslot < SEQ) ATT_LOADIK(ik, wslot);
#pragma unroll 1
    for (int t = wslot; t < SEQ; t += nslot) {
        const int tok = b * SEQ + t; const int nk = t + 1 < 256 ? t + 1 : 256; const bool full = t >= 256;
        const int tn = t + nslot;
        ATT_LOADIV(iv, t);
        if (tn < SEQ) ATT_LOADIK(nik, tn);
#define ATT_KIDX(T) ((ik[(T) >> 3][((T) >> 1) & 3] >> (((T) & 1) * 16)) & 0xffffu)
#define ATT_VIDX(ps, i) ((iv[(i) & 1][(4 * (ps) + ((i) >> 1)) >> 3][((4 * (ps) + ((i) >> 1)) >> 1) & 3] >> (((4 * (ps) + ((i) >> 1)) & 1) * 16)) & 0xffffu)
        bf16x8_t qb[2];
#pragma unroll
        for (int ks = 0; ks < 2; ++ks) { qb[ks] = (bf16x8_t){0, 0, 0, 0, 0, 0, 0, 0}; if (li < 8) qb[ks] = *(const bf16x8_t*)(bab + ((unsigned)t * 1280u + (unsigned)(li * 64 + 32 * ks + 8 * g) * 2u)); }
        f32x4 lg[16];
#pragma unroll
        for (int hb = 0; hb < 4; ++hb) {
            bf16x8_t ka[4][2];
#pragma unroll
            for (int T4 = 0; T4 < 4; ++T4) { const unsigned ko = (unsigned)ATT_KIDX(4 * hb + T4) * 1280u + koff; ka[T4][0] = *(const bf16x8_t*)(bab + ko); ka[T4][1] = *(const bf16x8_t*)(bab + ko + 64); }
#pragma unroll
            for (int T4 = 0; T4 < 4; ++T4) { f32x4 c = (f32x4){0.f, 0.f, 0.f, 0.f};
                c = __builtin_amdgcn_mfma_f32_16x16x32_bf16(ka[T4][0], qb[0], c, 0, 0, 0);
                c = __builtin_amdgcn_mfma_f32_16x16x32_bf16(ka[T4][1], qb[1], c, 0, 0, 0);
                lg[4 * hb + T4] = c; }
            __builtin_amdgcn_sched_barrier(0);
        }
        u32x4 vr[8];
#define ATT_LOADV(ps) do { _Pragma("unroll") for (int i = 0; i < 8; ++i) vr[i] = *(const u32x4*)(bab + ((unsigned)ATT_VIDX(ps, i) * 1280u + voff)); } while (0)
        ATT_LOADV(0);
        float mx = -3.0e38f;
#pragma unroll
        for (int T = 0; T < 16; ++T)
#pragma unroll
            for (int i = 0; i < 4; ++i) { if (!full && (16 * T + 4 * g + i) >= nk) lg[T][i] = -3.0e38f; mx = fmaxf(mx, lg[T][i]); }
        mx = fmaxf(mx, __shfl_xor(mx, 16)); mx = fmaxf(mx, __shfl_xor(mx, 32));
        float sm = 0.f;
#pragma unroll
        for (int T = 0; T < 16; ++T)
#pragma unroll
            for (int i = 0; i < 4; ++i) { const float e = __builtin_amdgcn_exp2f((lg[T][i] - mx) * 1.4426950408889634f); lg[T][i] = e; sm += e; }
        sm += __shfl_xor(sm, 16); sm += __shfl_xor(sm, 32);
        u32x4 pav[8];
#pragma unroll
        for (int ks2 = 0; ks2 < 8; ++ks2) { const f32x4 p0 = lg[2 * ks2], p1 = lg[2 * ks2 + 1]; pav[ks2] = (u32x4){pk2(p0[0], p0[1]), pk2(p0[2], p0[3]), pk2(p1[0], p1[1]), pk2(p1[2], p1[3])}; }
        f32x4 o[4];
#pragma unroll
        for (int nt = 0; nt < 4; ++nt) o[nt] = (f32x4){0.f, 0.f, 0.f, 0.f};
#pragma unroll
        for (int ps = 0; ps < 4; ++ps) {
#pragma unroll
            for (int i = 0; i < 8; ++i) *(LAS u32x4*)(vl + (8 * i + r8) * 160 + c8 * 16) = vr[i];
            __builtin_amdgcn_sched_barrier(0);
            if (ps < 3) ATT_LOADV(ps + 1);
#pragma unroll
            for (int k2 = 0; k2 < 2; ++k2) { const int ks2 = 2 * ps + k2;
                const bf16x8_t pa = __builtin_bit_cast(bf16x8_t, pav[ks2]);
                const int R0 = 32 * k2 + 4 * g + (li >> 2);
#pragma unroll
                for (int nt = 0; nt < 4; ++nt) {
                    const LAS unsigned char* ap = vl + R0 * 160 + (16 * nt + 4 * (li & 3)) * 2;
                    const v4i16_t lo = __builtin_amdgcn_ds_read_tr16_b64_v4i16((LAS v4i16_t*)ap);
                    const v4i16_t hi = __builtin_amdgcn_ds_read_tr16_b64_v4i16((LAS v4i16_t*)(ap + 16 * 160));
                    const bf16x8_t vb = (bf16x8_t){lo[0], lo[1], lo[2], lo[3], hi[0], hi[1], hi[2], hi[3]};
                    o[nt] = __builtin_amdgcn_mfma_f32_16x16x32_bf16(pa, vb, o[nt], 0, 0, 0);
                }
            }
            __builtin_amdgcn_sched_barrier(0);
        }
        { char* cq = (char*)(CAT + (size_t)tok * 1024 + 512); const unsigned coff = (unsigned)(4 * g * 64 + li) * 2u;
#pragma unroll
          for (int i = 0; i < 4; ++i) { const float s_h = __shfl(sm, (4 * g + i) & 15); const float inv = 1.0f / s_h;
            if (g < 2) {
#pragma unroll
                for (int nt = 0; nt < 4; ++nt) *(bf16*)(cq + (coff + (unsigned)(i * 64 + 16 * nt) * 2u)) = (bf16)f2bf(o[nt][i] * inv); } } }
#pragma unroll
        for (int z = 0; z < 2; ++z) ik[z] = nik[z];
    }
#undef ATT_LOADIK
#undef ATT_LOADIV
#undef ATT_KIDX
#undef ATT_VIDX
#undef ATT_LOADV
}
__device__ __forceinline__ void phase_norm1(Frame& F) {
    const bf16* MIX = (const bf16*)(F.ws + WS_MIX); bf16* HN2 = (bf16*)(F.ws + WS_HN2);
    const int gw = F.bid * NWAVES + F.wave, NGW = F.G * NWAVES, lane = F.lane;
    for (int m = gw; m < M; m += NGW) {
        const u32x2* mr = (const u32x2*)(MIX + (size_t)m * DM) + lane; const f32x4* xr = (const f32x4*)(F.x + (size_t)m * DM) + lane;
        const f32x4* g1 = (const f32x4*)F.g_mix_post + lane; const f32x4* g2 = (const f32x4*)F.g_ffn_pre + lane;
        f32x4 v[4]; float s = 0.f;
#pragma unroll
        for (int j = 0; j < 4; ++j) { const u32x2 w = mr[64 * j]; v[j] = (f32x4){bflo(w.x), bfhi(w.x), bflo(w.y), bfhi(w.y)}; s += (v[j].x * v[j].x + v[j].y * v[j].y) + (v[j].z * v[j].z + v[j].w * v[j].w); }
        const float rstd = 1.0f / sqrtf(wave_sum(s) * (1.f / DM) + EPS); float s2 = 0.f;
        f32x4* orow = (f32x4*)(F.out + (size_t)m * DM) + lane;
#pragma unroll
        for (int j = 0; j < 4; ++j) { v[j] = xr[64 * j] + v[j] * rstd * g1[64 * j]; orow[64 * j] = v[j]; s2 += (v[j].x * v[j].x + v[j].y * v[j].y) + (v[j].z * v[j].z + v[j].w * v[j].w); }
        const float rstd2 = 1.0f / sqrtf(wave_sum(s2) * (1.f / DM) + EPS);
        unsigned long long* o8 = (unsigned long long*)(HN2 + (size_t)m * DM) + lane;
#pragma unroll
        for (int j = 0; j < 4; ++j) { const f32x4 gg = g2[64 * j];
            o8[64 * j] = (unsigned long long)pk2(v[j].x * rstd2 * gg.x, v[j].y * rstd2 * gg.y) | ((unsigned long long)pk2(v[j].z * rstd2 * gg.z, v[j].w * rstd2 * gg.w) << 32); }
    }
}
__device__ __forceinline__ void phase_norm2(Frame& F) {
    const bf16* FFN = (const bf16*)(F.ws + WS_FFN);
    const int gw = F.bid * NWAVES + F.wave, NGW = F.G * NWAVES, lane = F.lane;
    for (int m = gw; m < M; m += NGW) {
        const u32x2* mr = (const u32x2*)(FFN + (size_t)m * DM) + lane; const f32x4* g1 = (const f32x4*)F.g_ffn_post + lane;
        f32x4 v[4]; float s = 0.f;
#pragma unroll
        for (int j = 0; j < 4; ++j) { const u32x2 w = mr[64 * j]; v[j] = (f32x4){bflo(w.x), bfhi(w.x), bflo(w.y), bfhi(w.y)}; s += (v[j].x * v[j].x + v[j].y * v[j].y) + (v[j].z * v[j].z + v[j].w * v[j].w); }
        const float rstd = 1.0f / sqrtf(wave_sum(s) * (1.f / DM) + EPS);
        f32x4* orow = (f32x4*)(F.out + (size_t)m * DM) + lane;
#pragma unroll
        for (int j = 0; j < 4; ++j) orow[64 * j] = orow[64 * j] + v[j] * rstd * g1[64 * j];
    }
}

__device__ __forceinline__ float dpp_shr1(float old, float src) { return __int_as_float(__builtin_amdgcn_update_dpp(__float_as_int(old), __float_as_int(src), 0x111, 0xf, 0xf, false)); }
__device__ __forceinline__ float dpp_shr2(float old, float src) { return __int_as_float(__builtin_amdgcn_update_dpp(__float_as_int(old), __float_as_int(src), 0x112, 0xf, 0xf, false)); }
__device__ __forceinline__ float dpp_ror1(float src) { return __int_as_float(__builtin_amdgcn_update_dpp(0, __float_as_int(src), 0x121, 0xf, 0xf, false)); }
__device__ __forceinline__ float dpp_ror2(float src) { return __int_as_float(__builtin_amdgcn_update_dpp(0, __float_as_int(src), 0x122, 0xf, 0xf, false)); }
struct EpiUp {
    static constexpr bool PERM = true, AFTER_DRAIN = false;
    unsigned char* ws; const float* conv_w; const float* conv_b;
    __device__ __forceinline__ void operator()(const pg8::f32x4 (&acc)[2][2][4][2], const pg8::Unit& u, int wr, int wc, int fr, int fq, PG8_LAS unsigned char* xl) const {
        PG8_LAS float* X = (PG8_LAS float*)xl;
        const int cl = 32 * wc + 8 * fq;
        if (fr >= 14) {
#pragma unroll
            for (int ai = 0; ai < 2; ++ai)
#pragma unroll
                for (int bj = 0; bj < 2; ++bj)
#pragma unroll
                    for (int n = 0; n < 2; ++n) *(PG8_LAS f32x4*)(X + ((ai * 2 + wr) * 2 + (fr - 14)) * 256 + bj * 128 + cl + 4 * n) = acc[ai][bj][3][n];
            if (wr == 1) { float* H = (float*)(ws + WS_HALO) + ((size_t)(u.pm * 22 + u.pn) * 2 + (fr - 14)) * 256;
#pragma unroll
                for (int bj = 0; bj < 2; ++bj)
#pragma unroll
                    for (int n = 0; n < 2; ++n) *(f32x4*)(H + bj * 128 + cl + 4 * n) = acc[1][bj][3][n]; }
        }
        asm volatile("s_waitcnt lgkmcnt(0)" ::: "memory"); __builtin_amdgcn_s_barrier(); asm volatile("" ::: "memory");
        const bool seq_start = (u.pm & 15) == 0;
        bf16* ACT = (bf16*)(ws + WS_ACT);
#pragma unroll
        for (int n = 0; n < 2; ++n) {
            f32x4 w0[2], w1[2], w2[2], bb[2];
#pragma unroll
            for (int bj = 0; bj < 2; ++bj) { const int ch = bj * DFF + 128 * u.pn + cl + 4 * n;
                w0[bj] = *(const f32x4*)(conv_w + ch); w1[bj] = *(const f32x4*)(conv_w + NUP + ch); w2[bj] = *(const f32x4*)(conv_w + 2 * NUP + ch); bb[bj] = *(const f32x4*)(conv_b + ch); }
#pragma unroll
            for (int ai = 0; ai < 2; ++ai) {
                const bool has_pred = !(ai == 0 && wr == 0);
                const int pai = (wr == 1) ? ai : 0, pwr = (wr == 1) ? 0 : 1;
#pragma unroll
                for (int m = 0; m < 4; ++m) {
                    f32x4 y[2];
#pragma unroll
                    for (int bj = 0; bj < 2; ++bj) {
                        const f32x4 cur = acc[ai][bj][m][n]; f32x4 p1, p2;
                        if (m == 0) {
                            f32x4 x0 = (f32x4){0.f, 0.f, 0.f, 0.f}, x1 = x0;
                            if (has_pred) { const PG8_LAS float* xp = X + ((pai * 2 + pwr) * 2) * 256 + bj * 128 + cl + 4 * n; x0 = *(const PG8_LAS f32x4*)xp; x1 = *(const PG8_LAS f32x4*)(xp + 256); }
                            const f32x4 o2 = (fr == 0) ? x0 : x1;
#pragma unroll
                            for (int e = 0; e < 4; ++e) { p1[e] = dpp_shr1(x1[e], cur[e]); p2[e] = dpp_shr2(o2[e], cur[e]); }
                        } else {
                            const f32x4 prv = acc[ai][bj][m > 0 ? m - 1 : 0][n];
#pragma unroll
                            for (int e = 0; e < 4; ++e) { p1[e] = dpp_shr1(dpp_ror1(prv[e]), cur[e]); p2[e] = dpp_shr2(dpp_ror2(prv[e]), cur[e]); }
                        }
                        y[bj] = bb[bj] + w2[bj] * cur + w1[bj] * p1 + w0[bj] * p2;
                    }
                    const int row = u.pm * 256 + ai * 128 + wr * 64 + m * 16 + fr;
                    const bool partial = (ai == 0 && wr == 0 && m == 0 && fr < 2 && !seq_start);
                    if (partial) { float* P = (float*)(ws + WS_PART) + ((size_t)(u.pm * 22 + u.pn) * 2 + fr) * 256 + cl + 4 * n; *(f32x4*)P = y[0]; *(f32x4*)(P + 128) = y[1]; }
                    else { f32x4 a;
#pragma unroll
                        for (int e = 0; e < 4; ++e) a[e] = silu_f(y[0][e]) * y[1][e];
                        u32x2 pk; pk.x = pk2(a[0], a[1]); pk.y = pk2(a[2], a[3]);
                        *(u32x2*)(ACT + (size_t)row * DFF + 128 * u.pn + cl + 4 * n) = pk; }
                    asm volatile("" ::: "memory");
                }
            }
        }
    }
};
__device__ __forceinline__ void phase_fixup(Frame& F) {
    const float* H = (const float*)(F.ws + WS_HALO); const float* P = (const float*)(F.ws + WS_PART); bf16* ACT = (bf16*)(F.ws + WS_ACT);
    const int total = 128 * 22 * 2 * 128;
    for (int i = F.bid * NTHREADS + F.tid; i < total; i += F.G * NTHREADS) {
        const int c = i & 127, j = (i >> 7) & 1, pn = (i >> 8) % 22, pm = (i >> 8) / 22;
        if ((pm & 15) == 0) continue;
        const float* pp = P + ((size_t)(pm * 22 + pn) * 2 + j) * 256; const float* hp = H + ((size_t)((pm - 1) * 22 + pn) * 2) * 256;
        float y[2];
#pragma unroll
        for (int bj = 0; bj < 2; ++bj) { const int ch = bj * DFF + 128 * pn + c; const float w0 = F.conv_w[ch], w1 = F.conv_w[NUP + ch];
            const float h0 = hp[bj * 128 + c], h1 = hp[256 + bj * 128 + c];
            y[bj] = pp[bj * 128 + c] + (j == 0 ? (w1 * h1 + w0 * h0) : (w0 * h1)); }
        ACT[(size_t)(pm * 256 + j) * DFF + 128 * pn + c] = (bf16)f2bf(silu_f(y[0]) * y[1]);
    }
}

#define XB_TMO      128
#define XB_XCNT(j)  (256  + 64 * (j))
#define XB_XSUB(j)  (1280 + 64 * (j))
#define XB_XGEN(j)  (2304 + 64 * (j))
#define XB_TOP      3328
#define XB_TOPGEN   3392
#define XCD_BAR_WORDS 3456
#define XB_SPIN_CAP (1u << 22)
__device__ __forceinline__ unsigned xb_ld(unsigned* p)              { return __hip_atomic_load(p, __ATOMIC_RELAXED, __HIP_MEMORY_SCOPE_AGENT); }
__device__ __forceinline__ unsigned xb_add(unsigned* p, unsigned v) { return __hip_atomic_fetch_add(p, v, __ATOMIC_RELAXED, __HIP_MEMORY_SCOPE_AGENT); }
__device__ __forceinline__ unsigned xb_xcc_id() { return (unsigned)__builtin_amdgcn_s_getreg((3 << 11) | 20) & 0xFu; }
#define XB_SPIN(cond, bar) do { unsigned _sp = 0; while (cond) { __builtin_amdgcn_s_sleep(1); \
    if ((++_sp & 255u) == 0u) { if (xb_ld(&(bar)[XB_TMO])) break; if (_sp > XB_SPIN_CAP) { atomicAdd(&(bar)[XB_TMO], 1u); break; } } } } while (0)
struct XcdBarrier { unsigned* bar; unsigned x; volatile LAS unsigned* st; };
__device__ __forceinline__ XcdBarrier xcd_barrier_post(unsigned* bar, volatile LAS unsigned* st) {
    XcdBarrier b; b.bar = bar; b.x = xb_xcc_id(); b.st = st;
    if (threadIdx.x == 0) (void)xb_add(&bar[XB_XCNT(b.x)], 1u);
    return b;
}
__device__ __forceinline__ void xcd_barrier_complete(unsigned* bar, unsigned x, unsigned& nloc, unsigned& nx) {
    const unsigned G = gridDim.x * gridDim.y * gridDim.z;
    unsigned sum, cnt, mine, sp = 0u;
    for (;;) {
        sum = 0u; cnt = 0u; mine = 0u;
#pragma unroll
        for (unsigned j = 0; j < 16; ++j) { const unsigned c = xb_ld(&bar[XB_XCNT(j)]); sum += c; cnt += (c > 0u) ? 1u : 0u; mine = (j == x) ? c : mine; }
        if (sum == G) break;
        __builtin_amdgcn_s_sleep(1);
        if ((++sp & 255u) == 0u) { if (xb_ld(&bar[XB_TMO])) break; if (sp > XB_SPIN_CAP) { atomicAdd(&bar[XB_TMO], 1u); break; } }
    }
    nloc = mine > 0u ? mine : 1u; nx = cnt > 0u ? cnt : 1u;
}
__device__ __forceinline__ void xcd_barrier(const XcdBarrier& b) {
    asm volatile("s_waitcnt vmcnt(0)" ::: "memory");
    __syncthreads();
    if (threadIdx.x == 0) {
        unsigned* bar = b.bar;
        __builtin_amdgcn_s_waitcnt(0);
        unsigned nloc = b.st[0], nx = b.st[1];
        if (nloc == 0u) { xcd_barrier_complete(bar, b.x, nloc, nx); b.st[0] = nloc; b.st[1] = nx; }
        const unsigned old = xb_add(&bar[XB_XSUB(b.x)], 1u);
        const unsigned gen = old / nloc;
        if (old + 1u == (gen + 1u) * nloc) {
            __builtin_amdgcn_fence(__ATOMIC_RELEASE, "agent");
            asm volatile("s_waitcnt vmcnt(0)" ::: "memory");
            const unsigned og = xb_add(&bar[XB_TOP], 1u);
            const unsigned tg = og / nx;
            if (og + 1u == (tg + 1u) * nx) xb_add(&bar[XB_TOPGEN], 1u);
            else XB_SPIN(xb_ld(&bar[XB_TOPGEN]) == tg, bar);
            __builtin_amdgcn_fence(__ATOMIC_ACQUIRE, "agent");
            xb_add(&bar[XB_XGEN(b.x)], 1u);
            asm volatile("s_waitcnt vmcnt(0)" ::: "memory");
        } else {
            XB_SPIN(xb_ld(&bar[XB_XGEN(b.x)]) == gen, bar);
            __builtin_amdgcn_fence(__ATOMIC_ACQUIRE, "agent");
            asm volatile("s_waitcnt vmcnt(0)" ::: "memory");
        }
    }
    __syncthreads();
}

__global__ void __launch_bounds__(NTHREADS, 2) hymba_fwd(Args args) {
    extern __shared__ __attribute__((aligned(16))) unsigned char lds_raw[];
    Frame F;
    F.lds = (LAS unsigned char*)lds_raw;
    F.tid = threadIdx.x; F.lane = F.tid & 63; F.wave = __builtin_amdgcn_readfirstlane(F.tid >> 6); F.G = gridDim.x; F.bid = blockIdx.x;
    F.x = args.in[0]; F.g_mix_pre = args.in[1]; F.g_mix_post = args.in[2]; F.w_in = args.in[3]; F.w_out = args.in[4]; F.g_ffn_pre = args.in[5]; F.g_ffn_post = args.in[6];
    F.w_up = args.in[7]; F.conv_w = args.in[8]; F.conv_b = args.in[9]; F.w_down = args.in[10]; F.out = args.out; F.ws = args.ws;
    const int lo = args.ph_lo, hi = args.ph_hi;
    cg::grid_group grid = cg::this_grid();
    volatile LAS unsigned* MISC = (volatile LAS unsigned*)(F.lds + LDS_MISC);
    if (F.tid < 16) MISC[F.tid] = 0u;
    __syncthreads();
    XcdBarrier bar; bar.bar = (unsigned*)(F.ws + WS_CTL); bar.x = 0; bar.st = nullptr;
    if (args.coop) bar = xcd_barrier_post((unsigned*)(F.ws + WS_CTL), MISC);
#define IN(k) (lo <= (k) && (k) < hi)
#ifndef PROBE_MASK
#define PROBE_MASK 0
#endif
#ifndef PROBE_REPS
#define PROBE_REPS 2
#endif
#define RUNPH(k, ...) do { if (IN(k)) { constexpr int _nr = ((PROBE_MASK >> (k)) & 1) ? PROBE_REPS : 1; _Pragma("unroll") for (int _r = 0; _r < _nr; ++_r) { __VA_ARGS__ if (_r + 1 < _nr) xcd_barrier(bar); } } SEAM(k); } while (0)
#define SEAM(k) do { if (IN(k) && IN((k) + 1)) { if (args.coop) { if ((k) == 0) grid.sync(); else xcd_barrier(bar); } } } while (0)
    RUNPH(0, phase_prologue(F););
    RUNPH(1, pg8::Gemm g{(const bf16*)(F.ws + WS_HN), (const bf16*)(F.ws + WS_WIN), M, NPROJ, DM}; pg8::StaticOrder S; S.init(M, NPROJ, F.G, F.bid);
        EpiProj E{F.ws}; pg8::gemm_phase<EpiProj, pg8::StaticOrder, true, true>(F.lds, g, S, E););
    RUNPH(2, phase_ret_state_mfma(F););
    RUNPH(3, phase_ret_scan(F););
    RUNPH(4, phase_ret_out_mfma(F););
    RUNPH(5, phase_idx_scores_mfma(F););
    RUNPH(6, phase_select(F););
    RUNPH(7, phase_attn_mfma(F););
    RUNPH(8, pg8::Gemm g{(const bf16*)(F.ws + WS_CAT), (const bf16*)(F.ws + WS_WOUT), M, DM, DM}; pg8::StaticOrder S; S.init(M, DM, F.G, F.bid);
        pg8::EpiStore E{(bf16*)(F.ws + WS_MIX), DM}; pg8::gemm_phase<pg8::EpiStore, pg8::StaticOrder, true, true>(F.lds, g, S, E););
    RUNPH(9, phase_norm1(F););
    RUNPH(10, pg8::Gemm g{(const bf16*)(F.ws + WS_HN2), (const bf16*)(F.ws + WS_WUP), M, NUP, DM}; pg8::StaticOrder S; S.init(M, NUP, F.G, F.bid);
        EpiUp E{F.ws, F.conv_w, F.conv_b}; pg8::gemm_phase<EpiUp, pg8::StaticOrder, true, true>(F.lds, g, S, E););
    RUNPH(11, phase_fixup(F););
    RUNPH(12, pg8::Gemm g{(const bf16*)(F.ws + WS_ACT), (const bf16*)(F.ws + WS_WDN), M, DM, DFF}; pg8::StaticOrder S; S.init(M, DM, F.G, F.bid);
        pg8::EpiStore E{(bf16*)(F.ws + WS_FFN), DM}; pg8::gemm_phase<pg8::EpiStore, pg8::StaticOrder, true, true>(F.lds, g, S, E););
    RUNPH(13, phase_norm2(F););
#undef IN
#undef SEAM
}

extern "C" void kernel_launch(void* const* d_in, const int* in_sizes, int n_in, void* d_out, int out_size, void* d_ws, size_t ws_size, hipStream_t stream) {
    static int grid = 0;
    if (grid == 0) {
        if (n_in != 11 || in_sizes[0] != M * DM || out_size != M * DM || ws_size < WS_END) { fprintf(stderr, "kernel_launch: unexpected shapes (n_in %d, in0 %d, out %d, ws %zu)\n", n_in, n_in > 0 ? in_sizes[0] : -1, out_size, ws_size); grid = -1; return; }
        int dev = 0, cus = 0, per_cu = 0;
        hipGetDevice(&dev); hipDeviceGetAttribute(&cus, hipDeviceAttributeMultiprocessorCount, dev);
        hipFuncSetAttribute((const void*)hymba_fwd, hipFuncAttributeMaxDynamicSharedMemorySize, LDS_BYTES);
        hipOccupancyMaxActiveBlocksPerMultiprocessor(&per_cu, (const void*)hymba_fwd, NTHREADS, LDS_BYTES);
        if (per_cu < 1) { fprintf(stderr, "kernel_launch: occupancy query says %d blocks per CU\n", per_cu); per_cu = 1; }
        (void)hipGetLastError();
        grid = cus * 1;
    }
    if (grid < 0) return;
    (void)hipMemsetAsync((char*)d_ws + WS_CTL, 0, 16384, stream);
    Args a{};
    for (int i = 0; i < 11; ++i) a.in[i] = (const float*)d_in[i];
    a.out = (float*)d_out; a.ws = (unsigned char*)d_ws;
#if MK_MULTI
    for (int p = 0; p < NPHASE; ++p) { a.ph_lo = p; a.ph_hi = p + 1; a.coop = 0; hipLaunchKernelGGL(hymba_fwd, dim3(grid), dim3(NTHREADS), LDS_BYTES, stream, a); }
#else
    a.ph_lo = 0; a.ph_hi = NPHASE; a.coop = 1;
    void* kargs[] = {&a};
    hipError_t e = hipLaunchCooperativeKernel((const void*)hymba_fwd, dim3(grid), dim3(NTHREADS), kargs, LDS_BYTES, stream);
    if (e != hipSuccess) fprintf(stderr, "cooperative launch failed: %s (grid %d)\n", hipGetErrorString(e), grid);
#endif
}
```
